# Optimizing an MI355X kernel written in HIP

```python
import math
import jax, jax.numpy as jnp
from jax import lax
import numpy as np

D_MODEL = 1024
BATCH = 8
SEQ = 2048
DEPTH = 4
DEC_BATCH = 128
DEC_SEQ = 4
PAST_LEN = 16384
PAGE_SIZE = 128

N_MIXERS = 4
D_PLE = 256
D_FF = 2816
EPS = 1e-6

GM_CHUNK = 128
GM_HALF = D_MODEL
GM_GROUPS = 8
GM_GROUP_DIM = GM_HALF // GM_GROUPS

POOL_WINDOWS = (2, 4, 8, 16)
POOL_GROUPS = len(POOL_WINDOWS)
POOL_GROUP_DIM = D_MODEL // POOL_GROUPS
POOL_HIST = max(POOL_WINDOWS) - 1

GLA_HEADS = 4
GLA_QK = D_MODEL // 2
GLA_V = D_MODEL
GLA_DK = GLA_QK // GLA_HEADS
GLA_DV = GLA_V // GLA_HEADS
GLA_RANK = 16
GLA_NORMALIZER = 16.0
GLA_CHUNK = 16

SSM_D_INNER = 2 * D_MODEL
SSM_HEAD_DIM = 64
SSM_HEADS = SSM_D_INNER // SSM_HEAD_DIM
SSM_GROUPS = 4
SSM_HPG = SSM_HEADS // SSM_GROUPS
SSM_STATE = 128
SSM_CONV = 4
SSM_CHUNK = 64
SSM_CONV_DIM = SSM_D_INNER + 2 * SSM_GROUPS * SSM_STATE

kernel_name = 'hybrid_macaron_chunkmlp_pool_gla_ssd_step'


def rms_norm(x, g):
    xf = x.astype(jnp.float32)
    y = xf * lax.rsqrt(jnp.mean(xf * xf, axis=-1, keepdims=True) + EPS)
    return (y * g.astype(jnp.float32)).astype(x.dtype)


def layer_norm(x, g):
    xf = x.astype(jnp.float32)
    xc = xf - jnp.mean(xf, axis=-1, keepdims=True)
    y = xc * lax.rsqrt(jnp.mean(xc * xc, axis=-1, keepdims=True) + EPS)
    return (y * g.astype(jnp.float32)).astype(x.dtype)


def swiglu(h, w_gate, w_up, w_down):
    return (jax.nn.silu(h @ w_gate) * (h @ w_up)) @ w_down


def pad_seq(t, multiple):
    pad = (-t.shape[1]) % multiple
    return jnp.pad(t, [(0, 0), (0, pad)] + [(0, 0)] * (t.ndim - 2))


def chunk_mlp_mixer(h, w_in, ln_g, w_s, b_s, w_out):
    B, L, _ = h.shape
    u, v = jnp.split(jax.nn.gelu(h @ w_in), 2, axis=-1)
    v = layer_norm(v, ln_g)
    vp = pad_seq(v, GM_CHUNK)
    nc = vp.shape[1] // GM_CHUNK
    vp = vp.reshape(B, nc, GM_CHUNK, GM_GROUPS, GM_GROUP_DIM)
    causal = jnp.tril(jnp.ones((GM_CHUNK, GM_CHUNK), dtype=bool))
    w_masked = jnp.where(causal[None], w_s, jnp.zeros_like(w_s))
    sv = jnp.einsum('gts,bnsgc->bntgc', w_masked, vp) + jnp.transpose(b_s)[None, None, :, :, None]
    sv = sv.reshape(B, nc * GM_CHUNK, GM_HALF)[:, :L]
    return (u * sv) @ w_out, v


def pool_mixer(h, hist, pos0, w_grp, scale):
    B, L, D = h.shape
    ext = jnp.concatenate([hist.astype(h.dtype), h], axis=1)
    cs = jnp.cumsum(ext.astype(jnp.float32), axis=1)
    cs = jnp.pad(cs, ((0, 0), (1, 0), (0, 0)))
    pos = pos0 + jnp.arange(L, dtype=jnp.int32)
    pooled = []
    for gi, w in enumerate(POOL_WINDOWS):
        lo, hi = gi * POOL_GROUP_DIM, (gi + 1) * POOL_GROUP_DIM
        win_sum = (cs[:, POOL_HIST + 1:POOL_HIST + 1 + L, lo:hi]
                   - cs[:, POOL_HIST + 1 - w:POOL_HIST + 1 - w + L, lo:hi])
        count = jnp.minimum(pos + 1, w).astype(jnp.float32)[None, :, None]
        pooled.append(win_sum / count)
    pooled = jnp.concatenate(pooled, axis=-1)
    diff = (pooled - h.astype(jnp.float32)).astype(h.dtype).reshape(B, L, POOL_GROUPS, POOL_GROUP_DIM)
    y = jnp.einsum('blgc,gcd->blgd', diff, w_grp).reshape(B, L, D) * scale
    return y, ext[:, -POOL_HIST:]


def gla_recurrence(q, k, v, log_a, s0):
    B, L, H, _ = q.shape
    DV = v.shape[-1]

    def blocks(t):
        t = pad_seq(t, GLA_CHUNK)
        nc = t.shape[1] // GLA_CHUNK
        return t.reshape(B, nc, GLA_CHUNK, H, t.shape[-1]).transpose(1, 0, 3, 2, 4)

    qc, kc, vc, gc = blocks(q), blocks(k), blocks(v), blocks(log_a)
    b = jnp.cumsum(gc, axis=3)
    b_last = b[:, :, :, -1:, :]
    q_dec = qc * jnp.exp(b)
    k_inv = kc * jnp.exp(-b)
    k_end = kc * jnp.exp(b_last - b)
    causal = jnp.tril(jnp.ones((GLA_CHUNK, GLA_CHUNK), dtype=bool))
    scores = jnp.where(causal, jnp.einsum('nbhtd,nbhsd->nbhts', q_dec, k_inv), 0.0)
    o_intra = jnp.einsum('nbhts,nbhsv->nbhtv', scores, vc)

    def step(s, xs):
        q_dec_c, k_end_c, v_c, decay_c = xs
        o_inter = jnp.einsum('bhtd,bhdv->bhtv', q_dec_c, s)
        s = s * decay_c[:, :, 0, :, None] + jnp.einsum('bhsd,bhsv->bhdv', k_end_c, v_c)
        return s, o_inter

    s_final, o_inter = lax.scan(step, s0, (q_dec, k_end, vc, jnp.exp(b_last)))
    o = (o_intra + o_inter).transpose(1, 0, 3, 2, 4).reshape(B, -1, H, DV)[:, :L]
    return o, s_final


def gla_mixer(h, s0, w_in, w_a1, w_a2, b_a, g_norm, w_out):
    B, L, _ = h.shape
    q, k, v, r = jnp.split(h @ w_in, [GLA_QK, 2 * GLA_QK, 2 * GLA_QK + GLA_V], axis=-1)
    log_a = jax.nn.log_sigmoid(((h @ w_a1) @ w_a2 + b_a).astype(jnp.float32)) / GLA_NORMALIZER
    qh = q.astype(jnp.float32).reshape(B, L, GLA_HEADS, GLA_DK) * (GLA_DK ** -0.5)
    kh = k.astype(jnp.float32).reshape(B, L, GLA_HEADS, GLA_DK)
    vh = v.astype(jnp.float32).reshape(B, L, GLA_HEADS, GLA_DV)
    o, s_new = gla_recurrence(qh, kh, vh, log_a.reshape(B, L, GLA_HEADS, GLA_DK), s0.astype(jnp.float32))
    o = rms_norm(o, g_norm.reshape(GLA_HEADS, GLA_DV)).astype(h.dtype).reshape(B, L, GLA_V)
    return (o * jax.nn.silu(r)) @ w_out, s_new.astype(s0.dtype)


def ssd_recurrence(x, dt, a, bm, cm, s0):
    B, L = x.shape[:2]

    def blocks(t):
        t = pad_seq(t, SSM_CHUNK)
        return t.reshape((B, t.shape[1] // SSM_CHUNK, SSM_CHUNK) + t.shape[2:])

    xc = blocks(x).reshape(B, -1, SSM_CHUNK, SSM_GROUPS, SSM_HPG, SSM_HEAD_DIM)
    dtc = blocks(dt).reshape(B, -1, SSM_CHUNK, SSM_GROUPS, SSM_HPG)
    bc, cc = blocks(bm), blocks(cm)
    cum = jnp.cumsum(dtc * a.reshape(SSM_GROUPS, SSM_HPG), axis=2)
    causal = jnp.tril(jnp.ones((SSM_CHUNK, SSM_CHUNK), dtype=bool))[:, :, None, None]
    seg = cum[:, :, :, None] - cum[:, :, None, :]
    decay = jnp.exp(jnp.where(causal, seg, -jnp.inf))
    cb = jnp.einsum('bctgn,bcsgn->bctsg', cc, bc)
    mix = cb[..., None] * decay * dtc[:, :, None]
    y_intra = jnp.einsum('bctsgr,bcsgrp->bctgrp', mix, xc)

    def step(s, xs):
        c_c, b_c, x_c, dt_c, cum_c = xs
        y_inter = jnp.einsum('btgn,bgrpn->btgrp', c_c, s) * jnp.exp(cum_c)[..., None]
        w_end = jnp.exp(cum_c[:, -1:] - cum_c) * dt_c
        s = s * jnp.exp(cum_c[:, -1])[..., None, None] + jnp.einsum('bsgn,bsgr,bsgrp->bgrpn', b_c, w_end, x_c)
        return s, y_inter

    to_scan = lambda t: jnp.moveaxis(t, 1, 0)
    s_init = s0.reshape(B, SSM_GROUPS, SSM_HPG, SSM_HEAD_DIM, SSM_STATE)
    s_final, y_inter = lax.scan(step, s_init, (to_scan(cc), to_scan(bc), to_scan(xc), to_scan(dtc), to_scan(cum)))
    y = (y_intra + jnp.moveaxis(y_inter, 0, 1)).reshape(B, -1, SSM_HEADS, SSM_HEAD_DIM)[:, :L]
    return y, s_final.reshape(B, SSM_HEADS, SSM_HEAD_DIM, SSM_STATE)


def ssd_mixer(h, conv_s0, ssm_s0, w_in, conv_w, conv_b, dt_bias, a_log, d_skip, g_norm, w_out):
    B, L, _ = h.shape
    z, xbc, dt = jnp.split(h @ w_in, [SSM_D_INNER, SSM_D_INNER + SSM_CONV_DIM], axis=-1)
    ext = jnp.concatenate([conv_s0.astype(h.dtype), xbc], axis=1)
    conv = conv_b + sum(ext[:, j:j + L] * conv_w[j] for j in range(SSM_CONV))
    xbc = jax.nn.silu(conv)
    xs, bm, cm = jnp.split(xbc, [SSM_D_INNER, SSM_D_INNER + SSM_GROUPS * SSM_STATE], axis=-1)
    dt = jax.nn.softplus((dt + dt_bias).astype(jnp.float32))
    a = -jnp.exp(a_log.astype(jnp.float32))
    xh = xs.astype(jnp.float32).reshape(B, L, SSM_HEADS, SSM_HEAD_DIM)
    y, s_new = ssd_recurrence(xh, dt, a,
                              bm.astype(jnp.float32).reshape(B, L, SSM_GROUPS, SSM_STATE),
                              cm.astype(jnp.float32).reshape(B, L, SSM_GROUPS, SSM_STATE),
                              ssm_s0.astype(jnp.float32))
    y = y + xh * d_skip.astype(jnp.float32)[:, None]
    y = y.reshape(B, L, SSM_D_INNER).astype(h.dtype) * jax.nn.silu(z)
    y = rms_norm(y.reshape(B, L, SSM_GROUPS, SSM_D_INNER // SSM_GROUPS),
                 g_norm.reshape(SSM_GROUPS, SSM_D_INNER // SSM_GROUPS)).reshape(B, L, SSM_D_INNER)
    return y @ w_out, ext[:, -(SSM_CONV - 1):], s_new.astype(ssm_s0.dtype)


def setup_inputs(seed: int = 0) -> dict:
    key = jax.random.key(seed)
    keys = iter(jax.random.split(key, 64))
    nk = lambda: next(keys)
    normal = lambda shape, s=1.0: jax.random.normal(nk(), shape, jnp.float32) * s
    dense = lambda shape, fan_in: normal(shape, fan_in ** -0.5)
    gain = lambda shape: 1.0 + normal(shape, 0.02)

    dt0 = jnp.exp(jax.random.uniform(nk(), (SSM_HEADS,), jnp.float32, math.log(1e-3), math.log(1e-1)))
    return {
        'x_prompt': normal((BATCH, SEQ, D_MODEL)),
        'x_sample': normal((DEC_BATCH, DEC_SEQ, D_MODEL)),
        'state_pool_l1': normal((DEC_BATCH, POOL_HIST, D_MODEL)),
        'state_gla_l2': normal((DEC_BATCH, GLA_HEADS, GLA_DK, GLA_DV), 0.5),
        'state_ssm_l3': normal((DEC_BATCH, SSM_HEADS, SSM_HEAD_DIM, SSM_STATE), 0.1),
        'state_conv_l3': normal((DEC_BATCH, SSM_CONV - 1, SSM_CONV_DIM)),
        'p_prompt': normal((DEPTH, BATCH, SEQ, D_PLE)),
        'p_sample': normal((DEPTH, DEC_BATCH, DEC_SEQ, D_PLE)),
        'norm_ffn1': gain((DEPTH, D_MODEL)),
        'ffn1_gate': dense((DEPTH, D_MODEL, D_FF), D_MODEL),
        'ffn1_up': dense((DEPTH, D_MODEL, D_FF), D_MODEL),
        'ffn1_down': dense((DEPTH, D_FF, D_MODEL), D_FF),
        'norm_mix': gain((DEPTH, D_MODEL)),
        'norm_ffn2': gain((DEPTH, D_MODEL)),
        'ffn2_gate': dense((DEPTH, D_MODEL, D_FF), D_MODEL),
        'ffn2_up': dense((DEPTH, D_MODEL, D_FF), D_MODEL),
        'ffn2_down': dense((DEPTH, D_FF, D_MODEL), D_FF),
        'norm_ple': gain((DEPTH, D_MODEL)),
        'ple_gate': dense((DEPTH, D_MODEL, D_MODEL), D_MODEL),
        'ple_proj': dense((DEPTH, D_PLE, D_MODEL), D_PLE),
        'norm_final': gain((D_MODEL,)),
        'gm_w_in': dense((D_MODEL, 2 * GM_HALF), D_MODEL),
        'gm_ln': gain((GM_HALF,)),
        'gm_w_s': dense((GM_GROUPS, GM_CHUNK, GM_CHUNK), GM_CHUNK),
        'gm_b_s': 1.0 + normal((GM_GROUPS, GM_CHUNK), 0.1),
        'gm_w_out': dense((GM_HALF, D_MODEL), GM_HALF),
        'pool_w': dense((POOL_GROUPS, POOL_GROUP_DIM, POOL_GROUP_DIM), POOL_GROUP_DIM),
        'pool_scale': gain((D_MODEL,)),
        'gla_w_in': dense((D_MODEL, 2 * GLA_QK + 2 * GLA_V), D_MODEL),
        'gla_w_a1': dense((D_MODEL, GLA_RANK), D_MODEL),
        'gla_w_a2': dense((GLA_RANK, GLA_QK), GLA_RANK),
        'gla_b_a': normal((GLA_QK,), 0.5),
        'gla_norm': gain((GLA_V,)),
        'gla_w_out': dense((GLA_V, D_MODEL), GLA_V),
        'ssm_w_in': dense((D_MODEL, 2 * SSM_D_INNER + 2 * SSM_GROUPS * SSM_STATE + SSM_HEADS), D_MODEL),
        'ssm_conv_w': dense((SSM_CONV, SSM_CONV_DIM), SSM_CONV),
        'ssm_conv_b': normal((SSM_CONV_DIM,), 0.02),
        'ssm_dt_bias': dt0 + jnp.log(-jnp.expm1(-dt0)),
        'ssm_a_log': jnp.log(jax.random.uniform(nk(), (SSM_HEADS,), jnp.float32, 1.0, 16.0)),
        'ssm_d': gain((SSM_HEADS,)),
        'ssm_norm': gain((SSM_D_INNER,)),
        'ssm_w_out': dense((SSM_D_INNER, D_MODEL), SSM_D_INNER),
    }


def reference(x_prompt, x_sample, state_pool_l1, state_gla_l2, state_ssm_l3, state_conv_l3,
              p_prompt, p_sample,
              norm_ffn1, ffn1_gate, ffn1_up, ffn1_down, norm_mix,
              norm_ffn2, ffn2_gate, ffn2_up, ffn2_down,
              norm_ple, ple_gate, ple_proj, norm_final,
              gm_w_in, gm_ln, gm_w_s, gm_b_s, gm_w_out,
              pool_w, pool_scale,
              gla_w_in, gla_w_a1, gla_w_a2, gla_b_a, gla_norm, gla_w_out,
              ssm_w_in, ssm_conv_w, ssm_conv_b, ssm_dt_bias, ssm_a_log, ssm_d, ssm_norm, ssm_w_out):

    def trunk(x, p, pos0, pool_hist, gla_s0, ssm_s0, conv_s0):
        for i in range(DEPTH):
            x = x + 0.5 * swiglu(rms_norm(x, norm_ffn1[i]), ffn1_gate[i], ffn1_up[i], ffn1_down[i])
            h = rms_norm(x, norm_mix[i])
            kind = i % N_MIXERS
            if kind == 0:
                mixed, chunk_v = chunk_mlp_mixer(h, gm_w_in, gm_ln, gm_w_s, gm_b_s, gm_w_out)
            elif kind == 1:
                mixed, pool_new = pool_mixer(h, pool_hist, pos0, pool_w, pool_scale)
            elif kind == 2:
                mixed, gla_new = gla_mixer(h, gla_s0, gla_w_in, gla_w_a1, gla_w_a2, gla_b_a, gla_norm, gla_w_out)
            else:
                mixed, conv_new, ssm_new = ssd_mixer(h, conv_s0, ssm_s0, ssm_w_in, ssm_conv_w, ssm_conv_b,
                                                     ssm_dt_bias, ssm_a_log, ssm_d, ssm_norm, ssm_w_out)
            x = x + mixed
            x = x + 0.5 * swiglu(rms_norm(x, norm_ffn2[i]), ffn2_gate[i], ffn2_up[i], ffn2_down[i])
            x = x + jax.nn.sigmoid(rms_norm(x, norm_ple[i]) @ ple_gate[i]) * (p[i] @ ple_proj[i])
        return rms_norm(x, norm_final), chunk_v, pool_new, gla_new, ssm_new, conv_new

    nb = x_prompt.shape[0]
    y_prompt, _, pool_prompt, gla_prompt, ssm_prompt, conv_prompt = trunk(
        x_prompt, p_prompt, 0,
        jnp.zeros((nb,) + state_pool_l1.shape[1:], state_pool_l1.dtype),
        jnp.zeros((nb,) + state_gla_l2.shape[1:], state_gla_l2.dtype),
        jnp.zeros((nb,) + state_ssm_l3.shape[1:], state_ssm_l3.dtype),
        jnp.zeros((nb,) + state_conv_l3.shape[1:], state_conv_l3.dtype))
    y_sample, chunk_v_sample, pool_sample, gla_sample, ssm_sample, conv_sample = trunk(
        x_sample, p_sample, PAST_LEN, state_pool_l1, state_gla_l2, state_ssm_l3, state_conv_l3)
    return (y_prompt, y_sample, chunk_v_sample, pool_prompt, pool_sample, gla_prompt, gla_sample,
            ssm_prompt, ssm_sample, conv_prompt, conv_sample)
```

```cpp
#include <hip/hip_runtime.h>
#include <hip/hip_cooperative_groups.h>
#include <cstdio>
#include <cstdint>
namespace cg = cooperative_groups;

#define LAS __attribute__((address_space(3)))
#define DI __device__ __forceinline__
typedef unsigned short bf16_t;
typedef short bf16x8 __attribute__((ext_vector_type(8)));
typedef float f32x4 __attribute__((ext_vector_type(4)));
typedef unsigned u32x4 __attribute__((ext_vector_type(4)));
typedef unsigned u32x2 __attribute__((ext_vector_type(2)));

constexpr int T = 16896, TP = 16384, DM = 1024, FF = 2816;
constexpr float EPS = 1e-6f;
constexpr int NPHASES = 41;

constexpr size_t SZ_W1 = (size_t)5632 * 1024 * 2, SZ_D1 = (size_t)1024 * 2816 * 2, SZ_SQ = (size_t)1024 * 1024 * 2, SZ_PPW = (size_t)1024 * 256 * 2;
constexpr size_t O_W1 = 0;
constexpr size_t O_D1 = O_W1 + 4 * SZ_W1;
constexpr size_t O_W2 = O_D1 + 4 * SZ_D1;
constexpr size_t O_D2 = O_W2 + 4 * SZ_W1;
constexpr size_t O_PG = O_D2 + 4 * SZ_D1;
constexpr size_t O_PPW = O_PG + 4 * SZ_SQ;
constexpr size_t O_GMIN = O_PPW + 4 * SZ_PPW;
constexpr size_t O_GMOUT = O_GMIN + (size_t)2048 * 1024 * 2;
constexpr size_t O_POOLW = O_GMOUT + SZ_SQ;
constexpr size_t O_GLAIN = O_POOLW + (size_t)1024 * 256 * 2;
constexpr size_t O_GLAOUT = O_GLAIN + (size_t)3328 * 1024 * 2;
constexpr size_t O_SSMIN = O_GLAOUT + SZ_SQ;
constexpr size_t O_SSMOUT = O_SSMIN + (size_t)5376 * 1024 * 2;
constexpr size_t O_WSB = O_SSMOUT + (size_t)1024 * 2048 * 2;
constexpr size_t O_X = O_WSB + (size_t)8 * 128 * 128 * 2;
constexpr size_t O_XB = O_X + (size_t)T * 1024 * 4;
constexpr size_t O_ST = O_XB + (size_t)T * 1024 * 2;
constexpr size_t O_PBF = O_ST + (size_t)192 * T * 4;
constexpr size_t ST_GSP = (size_t)32 * T, ST_GSSP = (size_t)64 * T, ST_SSSP = (size_t)128 * T;
constexpr size_t O_PP = O_PBF + (size_t)T * 256 * 2;
constexpr size_t O_XB2 = O_PP + (size_t)T * 1024 * 2;
constexpr size_t O_R = O_XB2 + (size_t)T * 1024 * 2;
constexpr size_t R_ACT = 0;
constexpr size_t R_U = 0, R_V = R_U + (size_t)T * 1024 * 2, R_GU = R_V + (size_t)T * 1024 * 2;
constexpr size_t R_DIFF = 0;
constexpr size_t R_QKVR = 0, R_T16 = R_QKVR + (size_t)T * 3072 * 2, R_QD = R_T16 + (size_t)T * 16 * 4, R_KI = R_QD + (size_t)T * 512 * 2,
                 R_DEC = R_KI + (size_t)T * 512 * 2, R_SA = R_DEC + (size_t)256 * 512 * 4, R_OBUF = R_SA + (size_t)512 * 512 * 4;
constexpr size_t R_Z = 0, R_XBC = R_Z + (size_t)T * 2048 * 2, R_XBCS = R_XBC + (size_t)T * 3072 * 2, R_DTR = R_XBCS + (size_t)T * 3072 * 2,
                 R_DT = R_DTR + (size_t)T * 32 * 4, R_END = R_DT + (size_t)T * 32 * 4;
constexpr size_t R_YBUF = R_XBC;
constexpr size_t O_BAR = O_R + R_END;
constexpr size_t WS_TOTAL = O_BAR + 16384;
constexpr size_t OUT_Y = 0, OUT_CV = 17301504, OUT_POOLP = 17825792, OUT_POOLS = 17948672, OUT_GLAP = 19914752, OUT_GLAS = 20963328,
                 OUT_SSMP = 37740544, OUT_SSMS = 39837696, OUT_CONVP = 73392128, OUT_CONVS = 73465856;

enum { I_XP = 0, I_XS, I_SPOOL, I_SGLA, I_SSSM, I_SCONV, I_PP, I_PS, I_NF1, I_F1G, I_F1U, I_F1D, I_NMIX, I_NF2, I_F2G, I_F2U, I_F2D, I_NPLE, I_PLEG, I_PLEP,
       I_NFIN, I_GMIN, I_GMLN, I_GMWS, I_GMBS, I_GMOUT, I_POOLW, I_POOLSC, I_GLAIN, I_GLAA1, I_GLAA2, I_GLABA, I_GLANORM, I_GLAOUT, I_SSMIN, I_SSMCW, I_SSMCB,
       I_SSMDTB, I_SSMALOG, I_SSMD, I_SSMNORM, I_SSMOUT, N_IN };

struct Params { const float* in[N_IN]; float* out; unsigned char* ws; };
__device__ __forceinline__ const Params& fresh_params() {
    auto kp = __builtin_amdgcn_kernarg_segment_ptr();
    asm volatile("" : "+s"(kp));
    return *(const Params*)kp;
}

__device__ __forceinline__ int tid_() { int t = (int)threadIdx.x; asm volatile("" : "+v"(t)); return t & 511; }
__device__ __forceinline__ int bid_() { int b = (int)blockIdx.x; asm volatile("" : "+s"(b)); return b; }
__device__ __forceinline__ int gdim_() { int g = (int)gridDim.x; asm volatile("" : "+s"(g)); return g; }
typedef float f32x2v __attribute__((ext_vector_type(2)));
typedef __bf16 bf16x2v __attribute__((ext_vector_type(2)));
DI unsigned pk2(float lo, float hi) { const f32x2v v = {lo, hi}; const bf16x2v b = __builtin_convertvector(v, bf16x2v); return __builtin_bit_cast(unsigned, b); }
DI float bflo(unsigned w) { return __uint_as_float(w << 16); }
DI float bfhi(unsigned w) { return __uint_as_float(w & 0xffff0000u); }
DI float bf2f(bf16_t b) { return __uint_as_float(((unsigned)b) << 16); }
DI bf16_t f2bf(float f) { return (bf16_t)(pk2(f, 0.f) & 0xffffu); }
DI float sigmoidf_(float x) { return __builtin_amdgcn_rcpf(1.0f + __expf(-x)); }
DI float siluf_(float x) { return x * sigmoidf_(x); }
DI float geluf_(float x) { return x * sigmoidf_(1.5957691216f * (x + 0.044715f * x * x * x)); }
DI float softplusf_(float x) { return fmaxf(x, 0.f) + __logf(1.0f + __expf(-fabsf(x))); }
DI void unpack8(const u32x4& w, float* f) { f[0] = bflo(w.x); f[1] = bfhi(w.x); f[2] = bflo(w.y); f[3] = bfhi(w.y); f[4] = bflo(w.z); f[5] = bfhi(w.z); f[6] = bflo(w.w); f[7] = bfhi(w.w); }
DI u32x4 pack8(const float* f) { u32x4 w; w.x = pk2(f[0], f[1]); w.y = pk2(f[2], f[3]); w.z = pk2(f[4], f[5]); w.w = pk2(f[6], f[7]); return w; }
DI float rs_of(float ss, float inv_n) { return __builtin_amdgcn_rsqf(ss * inv_n + EPS); }
DI void atomic_add_f32(float* p, float v) {
    [[clang::atomic(no_remote_memory, no_fine_grained_memory, ignore_denormal_mode)]] { (void)__hip_atomic_fetch_add(p, v, __ATOMIC_RELAXED, __HIP_MEMORY_SCOPE_AGENT); }
}
DI float sum16(const float* p) { const f32x4 a = *(const f32x4*)p, b = *(const f32x4*)(p + 4), c = *(const f32x4*)(p + 8), d = *(const f32x4*)(p + 12); const f32x4 s = (a + b) + (c + d); return (s[0] + s[1]) + (s[2] + s[3]); }
#define LDS_BARRIER() do { asm volatile("s_waitcnt lgkmcnt(0)" ::: "memory"); __builtin_amdgcn_s_barrier(); asm volatile("" ::: "memory"); } while (0)
DI float sum16_fq(const float* p, int fq) { const f32x4 a = *(const f32x4*)(p + 4 * fq); float s = (a[0] + a[1]) + (a[2] + a[3]); s += __shfl_xor(s, 16); s += __shfl_xor(s, 32); return s; }
#define MFMA16(a, b, c) __builtin_amdgcn_mfma_f32_16x16x32_bf16((a), (b), (c), 0, 0, 0)

constexpr int BM = 256, BK = 64, HALF = 128, HTB = HALF * BK * 2;
DI int lds_byte(int r, int c) { const int st = (r >> 4) * 2 + (c >> 5), rr = r & 15, cc = c & 31, ob = rr * 64 + cc * 2; return st * 1024 + (ob ^ (((ob >> 9) & 1) << 5)); }
DI void stage_rc(int b, int& R, int& C) { const int st = b / 1024, sb = b % 1024, swz = sb ^ (((sb >> 9) & 1) << 5); R = (st >> 1) * 16 + swz / 64; C = (st & 1) * 32 + (swz % 64) / 2; }
DI int perm32(int rho) { const int n = rho >> 4, i = rho & 15; return 8 * (i >> 2) + 4 * n + (i & 3); }

enum { K_P0 = 0, K_A, K_B, K_D, K_E, K_PP, K_F, K_GM1, K_GM2, K_GM3, K_PL1, K_PL2, K_GL1, K_GL2, K_GL3, K_GL4, K_GL5, K_SS1, K_SS2, K_SS3, K_SS4, K_SS5, K_FIN, K_NOP };
struct Unit { int pm, pn; };
struct GemmD { const bf16_t* A; const bf16_t* Bt; int lda, ldb, a_pn_off, nM, nN, K; };
enum { EM_SWIGLU = 0, EM_RESID, EM_PLE, EM_PLAIN, EM_GMIN, EM_GLAIN, EM_SSMIN };
struct EpiD { int mode; float alpha; const float* xin; float* x; bf16_t* xb; const float* ss_in; float* ss_out; bf16_t* o0; bf16_t* o1; float* f0; const float* cs; const bf16_t* ppb; };

DI bool unit_at(const GemmD& g, int i, int G, int c, Unit& u) {
    const int nwg = g.nM * g.nN; const long L = (long)i * G + c; if (L >= nwg) return false;
    int wgid = (int)L; { const int q = nwg / 8, r = nwg % 8, xcd = wgid % 8, off = wgid / 8; wgid = (xcd < r ? xcd * (q + 1) : r * (q + 1) + (xcd - r) * q) + off; }
    const int nig = 8 * g.nN, gid = wgid / nig, fm = gid * 8, gsz = (g.nM - fm) < 8 ? (g.nM - fm) : 8;
    u.pm = fm + ((wgid % nig) % gsz); u.pn = (wgid % nig) / gsz; return true;
}

DI EpiD make_epi(int kind, int l, bool mini = false);
DI void epilogue(int kind, int l, const f32x4 (&acc)[2][2][4][2], const Unit& u, int wr, int wc, int fr, int fq) {
    const EpiD E = make_epi(kind, l);
    const int row0 = u.pm * BM + wr * 64 + fr, col0 = u.pn * BM + wc * 32 + 8 * fq;
    if (E.mode == EM_SWIGLU) {
#pragma unroll
        for (int ai = 0; ai < 2; ++ai)
#pragma unroll
            for (int m = 0; m < 4; ++m) { const int row = row0 + ai * HALF + m * 16; const float rs = rs_of(sum16_fq(E.ss_in + (size_t)row * 16, fq), 1.f / 1024.f);
#pragma unroll
                for (int bj = 0; bj < 2; ++bj) { const f32x4 g = acc[ai][bj][m][0] * rs, up = acc[ai][bj][m][1] * rs;
                    u32x2 w; w.x = pk2(siluf_(g[0]) * up[0], siluf_(g[1]) * up[1]); w.y = pk2(siluf_(g[2]) * up[2], siluf_(g[3]) * up[3]);
                    *(u32x2*)(E.o0 + (size_t)row * FF + ((col0 + bj * HALF) >> 1)) = w; } }
    } else if (E.mode == EM_RESID || E.mode == EM_PLE) {
        const bool ple = E.mode == EM_PLE;
#pragma unroll
        for (int ai = 0; ai < 2; ++ai)
#pragma unroll
            for (int m = 0; m < 4; ++m) { const int row = row0 + ai * HALF + m * 16; float sq = 0.f;
                const float rs = ple ? rs_of(sum16_fq(E.ss_in + (size_t)row * 16, fq), 1.f / 1024.f) : 0.f;
#pragma unroll
                for (int bj = 0; bj < 2; ++bj) { const int col = col0 + bj * HALF; float* xp = E.x + (size_t)row * DM + col; const float* xi = E.xin + (size_t)row * DM + col;
                    f32x4 x0 = *(const f32x4*)xi, x1 = *(const f32x4*)(xi + 4); f32x4 v0 = acc[ai][bj][m][0], v1 = acc[ai][bj][m][1];
                    if (ple) { const u32x4 pw = *(const u32x4*)(E.ppb + (size_t)row * DM + col); float pf[8]; unpack8(pw, pf);
#pragma unroll
                        for (int j = 0; j < 4; ++j) { x0[j] += sigmoidf_(v0[j] * rs) * pf[j] * E.alpha; x1[j] += sigmoidf_(v1[j] * rs) * pf[4 + j] * E.alpha; }
                    } else if (E.cs) { const f32x4 c0 = *(const f32x4*)(E.cs + col), c1 = *(const f32x4*)(E.cs + col + 4); x0 += v0 * c0 * E.alpha; x1 += v1 * c1 * E.alpha; }
                    else { x0 += v0 * E.alpha; x1 += v1 * E.alpha; }
                    *(f32x4*)xp = x0; *(f32x4*)(xp + 4) = x1;
                    u32x4 w; w.x = pk2(x0[0], x0[1]); w.y = pk2(x0[2], x0[3]); w.z = pk2(x1[0], x1[1]); w.w = pk2(x1[2], x1[3]);
                    *(u32x4*)(E.xb + (size_t)row * DM + col) = w;
                    sq += (x0[0] * x0[0] + x0[1] * x0[1]) + (x0[2] * x0[2] + x0[3] * x0[3]) + (x1[0] * x1[0] + x1[1] * x1[1]) + (x1[2] * x1[2] + x1[3] * x1[3]); }
                sq += __shfl_xor(sq, 16); sq += __shfl_xor(sq, 32);
                if (fq == 0) E.ss_out[(size_t)row * 16 + u.pn * 4 + wc] = sq; }
    } else if (E.mode == EM_PLAIN) {
#pragma unroll
        for (int ai = 0; ai < 2; ++ai)
#pragma unroll
            for (int m = 0; m < 4; ++m) { const int row = row0 + ai * HALF + m * 16;
#pragma unroll
                for (int bj = 0; bj < 2; ++bj) { const f32x4 v0 = acc[ai][bj][m][0], v1 = acc[ai][bj][m][1];
                    u32x4 w; w.x = pk2(v0[0], v0[1]); w.y = pk2(v0[2], v0[3]); w.z = pk2(v1[0], v1[1]); w.w = pk2(v1[2], v1[3]);
                    *(u32x4*)(E.o0 + (size_t)row * DM + col0 + bj * HALF) = w; } }
    } else if (E.mode == EM_GMIN) {
        const bool isv = u.pn >= 4;
#pragma unroll
        for (int ai = 0; ai < 2; ++ai)
#pragma unroll
            for (int m = 0; m < 4; ++m) { const int row = row0 + ai * HALF + m * 16; const float rs = rs_of(sum16_fq(E.ss_in + (size_t)row * 16, fq), 1.f / 1024.f); float s1 = 0.f, s2 = 0.f;
#pragma unroll
                for (int bj = 0; bj < 2; ++bj) { const int col = col0 + bj * HALF; float v[8];
#pragma unroll
                    for (int j = 0; j < 4; ++j) { v[j] = geluf_(acc[ai][bj][m][0][j] * rs); v[4 + j] = geluf_(acc[ai][bj][m][1][j] * rs); }
                    const u32x4 w = pack8(v);
                    if (isv) { *(u32x4*)(E.o1 + (size_t)row * DM + col - 1024) = w;
#pragma unroll
                        for (int j = 0; j < 8; ++j) { s1 += v[j]; s2 += v[j] * v[j]; } }
                    else *(u32x4*)(E.o0 + (size_t)row * DM + col) = w; }
                if (isv) { s1 += __shfl_xor(s1, 16); s1 += __shfl_xor(s1, 32); s2 += __shfl_xor(s2, 16); s2 += __shfl_xor(s2, 32);
                    if (fq == 0) { float* gp = E.f0 + (size_t)row * 32 + ((u.pn - 4) * 4 + wc) * 2; gp[0] = s1; gp[1] = s2; } } }
    } else if (E.mode == EM_GLAIN) {
#pragma unroll
        for (int ai = 0; ai < 2; ++ai)
#pragma unroll
            for (int m = 0; m < 4; ++m) { const int row = row0 + ai * HALF + m * 16; float rs = rs_of(sum16_fq(E.ss_in + (size_t)row * 16, fq), 1.f / 1024.f);
                if (u.pn < 2) rs *= 0.08838834764831845f;
#pragma unroll
                for (int bj = 0; bj < 2; ++bj) { const int col = col0 + bj * HALF; const f32x4 v0 = acc[ai][bj][m][0] * rs, v1 = acc[ai][bj][m][1] * rs;
                    if (col < 3072) { u32x4 w; w.x = pk2(v0[0], v0[1]); w.y = pk2(v0[2], v0[3]); w.z = pk2(v1[0], v1[1]); w.w = pk2(v1[2], v1[3]);
                        *(u32x4*)(E.o0 + (size_t)row * 3072 + col) = w; }
                    else if (col < 3088) { float* tp = E.f0 + (size_t)row * 16 + (col - 3072); *(f32x4*)tp = v0; *(f32x4*)(tp + 4) = v1; } } }
    } else {
#pragma unroll
        for (int ai = 0; ai < 2; ++ai)
#pragma unroll
            for (int m = 0; m < 4; ++m) { const int row = row0 + ai * HALF + m * 16; const float rs = rs_of(sum16_fq(E.ss_in + (size_t)row * 16, fq), 1.f / 1024.f);
#pragma unroll
                for (int bj = 0; bj < 2; ++bj) { const int col = col0 + bj * HALF; const f32x4 v0 = acc[ai][bj][m][0] * rs, v1 = acc[ai][bj][m][1] * rs;
                    if (col < 5120) { u32x4 w; w.x = pk2(v0[0], v0[1]); w.y = pk2(v0[2], v0[3]); w.z = pk2(v1[0], v1[1]); w.w = pk2(v1[2], v1[3]);
                        if (col < 2048) *(u32x4*)(E.o0 + (size_t)row * 2048 + col) = w; else *(u32x4*)(E.o1 + (size_t)row * 3072 + (col - 2048)) = w; }
                    else if (col < 5152) { float* tp = E.f0 + (size_t)row * 32 + (col - 5120); *(f32x4*)tp = v0; *(f32x4*)(tp + 4) = v1; } } }
    }
}

DI EpiD make_epi(int kind, int l, bool mini) {
    const Params& P = fresh_params(); unsigned char* ws = P.ws;
    float* ST = (float*)(ws + O_ST);
    EpiD e; e.mode = EM_RESID; e.alpha = 1.f; e.x = (float*)(ws + O_X); e.xin = e.x; e.xb = (bf16_t*)(ws + O_XB); e.ss_in = nullptr; e.ss_out = nullptr; e.o0 = nullptr; e.o1 = nullptr; e.f0 = nullptr; e.cs = nullptr; e.ppb = nullptr;
    switch (kind) {
    case K_A: case K_D: e.mode = EM_SWIGLU; e.ss_in = ST; e.o0 = (bf16_t*)(ws + O_R + R_ACT); break;
    case K_B: case K_E: e.alpha = 0.5f; e.ss_out = ST + (size_t)16 * T;
        if (kind == K_B && l == 0) e.xin = mini ? P.in[I_XS] - (size_t)TP * DM : P.in[I_XP];
        break;
    case K_PP: e.mode = EM_PLAIN; e.o0 = (bf16_t*)(ws + O_PP); break;
    case K_F: e.mode = EM_PLE; e.xb = (bf16_t*)(ws + O_XB2); e.ss_in = ST + (size_t)16 * T; e.ss_out = ST; e.ppb = (const bf16_t*)(ws + O_PP); break;
    case K_GM1: e.mode = EM_GMIN; e.ss_in = ST + (size_t)16 * T; e.o0 = (bf16_t*)(ws + O_R + R_U); e.o1 = (bf16_t*)(ws + O_R + R_V); e.f0 = ST + ST_GSP; break;
    case K_GM3: e.ss_out = ST; break;
    case K_PL2: e.cs = P.in[I_POOLSC]; e.ss_out = ST; break;
    case K_GL1: e.mode = EM_GLAIN; e.ss_in = ST + (size_t)16 * T; e.o0 = (bf16_t*)(ws + O_R + R_QKVR); e.f0 = (float*)(ws + O_R + R_T16); break;
    case K_GL5: e.ss_out = ST; break;
    case K_SS1: e.mode = EM_SSMIN; e.ss_in = ST + (size_t)16 * T; e.o0 = (bf16_t*)(ws + O_R + R_Z); e.o1 = (bf16_t*)(ws + O_R + R_XBC); e.f0 = (float*)(ws + O_R + R_DTR); break;
    default: e.ss_out = ST; break;
    }
    return e;
}

DI void gemm_phase(LAS unsigned char* lds, const GemmD g, const int kind, const int l) {
    const int tid = tid_(), wid = __builtin_amdgcn_readfirstlane(tid >> 6), lane = tid & 63, wr = wid >> 2, wc = wid & 3, fr = lane & 15, fq = lane >> 4;
    const int K = g.K, nt = K / BK; const int G = gdim_(), c = bid_();
    unsigned voffA[2], voffB[2];
#pragma unroll
    for (int i = 0; i < 2; ++i) { int R, C; stage_rc(tid * 16 + i * 8192, R, C); const int Rb = (R & ~31) + perm32(R & 31);
        voffA[i] = (unsigned)(R * g.lda + C) * 2u; voffB[i] = (unsigned)(Rb * g.ldb + C) * 2u; }
    const size_t kstep = (size_t)(BK * 2);
    const size_t hstepA = (size_t)HALF * g.lda * 2, hstepB = (size_t)HALF * g.ldb * 2;
    const size_t tstepA = 2 * hstepA, tstepB = 2 * hstepB, pnA = (size_t)g.a_pn_off * 2;
    const unsigned ldsw = (unsigned)wid * 1024u;
    const int aoff = lds_byte(wr * 64 + fr, fq * 8), boff = lds_byte(wc * 32 + fr, fq * 8);
#define PG8_SA(b, h) (((b) * 2 + (h)) * HTB)
#define PG8_SB(b, h) ((4 + (b) * 2 + (h)) * HTB)
#define PG8_STAGE(bufoff, gbase, voff) do { _Pragma("unroll") for (int _i = 0; _i < 2; ++_i) \
        __builtin_amdgcn_global_load_lds((const unsigned*)((const char*)(gbase) + (voff)[_i]), (LAS unsigned*)(lds + (bufoff) + ldsw + _i * 8192), 16, 0, 0); } while (0)
#define PG8_LDA(dst, b, h) do { _Pragma("unroll") for (int m = 0; m < 4; ++m) _Pragma("unroll") for (int k = 0; k < 2; ++k) dst[m][k] = *(const LAS bf16x8*)(lds + PG8_SA(b, h) + aoff + m * 2048 + k * 1024); } while (0)
#define PG8_LDB(dst, b, h) do { _Pragma("unroll") for (int n = 0; n < 2; ++n) _Pragma("unroll") for (int k = 0; k < 2; ++k) dst[n][k] = *(const LAS bf16x8*)(lds + PG8_SB(b, h) + boff + n * 2048 + k * 1024); } while (0)
#define PG8_MMA(ai, bj, At, Bt) do { __builtin_amdgcn_s_setprio(1); _Pragma("unroll") for (int m = 0; m < 4; ++m) _Pragma("unroll") for (int n = 0; n < 2; ++n) _Pragma("unroll") for (int k = 0; k < 2; ++k) \
        acc[ai][bj][m][n] = __builtin_amdgcn_mfma_f32_16x16x32_bf16(Bt[n][k], At[m][k], acc[ai][bj][m][n], 0, 0, 0); __builtin_amdgcn_s_setprio(0); } while (0)
#define PG8_WAIT_V(n) asm volatile("s_waitcnt vmcnt(" #n ")" ::: "memory")
#define PG8_WAIT_L(n) asm volatile("s_waitcnt lgkmcnt(" #n ")" ::: "memory")
#define PG8_BAR __builtin_amdgcn_s_barrier()
#define PG8_SCHED __builtin_amdgcn_sched_barrier(0)
    Unit cur, nxt; int ui = 0;
    if (!unit_at(g, 0, G, c, cur)) return;
    f32x4 acc[2][2][4][2];
#pragma unroll
    for (int a = 0; a < 2; ++a)
#pragma unroll
        for (int b = 0; b < 2; ++b)
#pragma unroll
            for (int m = 0; m < 4; ++m)
#pragma unroll
                for (int n = 0; n < 2; ++n) acc[a][b][m][n] = (f32x4){0.f, 0.f, 0.f, 0.f};
    bf16x8 At[4][2], B0[2][2], B1[2][2];
    const char* cA = (const char*)g.A + (size_t)cur.pm * tstepA + (size_t)cur.pn * pnA; const char* cB = (const char*)g.Bt + (size_t)cur.pn * tstepB;
    PG8_STAGE(PG8_SB(0, 0), cB, voffB); PG8_STAGE(PG8_SB(0, 1), cB + hstepB, voffB); PG8_STAGE(PG8_SA(0, 0), cA, voffA); PG8_STAGE(PG8_SA(0, 1), cA + hstepA, voffA);
    if (wr == 1) PG8_BAR;
    PG8_WAIT_V(2); PG8_BAR;
    PG8_STAGE(PG8_SB(1, 0), cB + kstep, voffB); PG8_STAGE(PG8_SA(1, 0), cA + kstep, voffA); PG8_STAGE(PG8_SB(1, 1), cB + hstepB + kstep, voffB);
    PG8_WAIT_V(6); PG8_BAR;
    for (;;) {
        const bool has_next = unit_at(g, ui + 1, G, c, nxt);
        const char* nA = has_next ? (const char*)g.A + (size_t)nxt.pm * tstepA + (size_t)nxt.pn * pnA : cA; const char* nB = has_next ? (const char*)g.Bt + (size_t)nxt.pn * tstepB : cB;
        for (int t = 0; t < nt; t += 2) {
            const bool last = (t == nt - 2);
            const char* a1 = cA + (size_t)(t + 1) * kstep;
            const char* a2 = last ? nA : cA + (size_t)(t + 2) * kstep; const char* b2 = last ? nB : cB + (size_t)(t + 2) * kstep;
            const char* a3 = a2 + kstep; const char* b3 = b2 + kstep;
            PG8_LDB(B0, 0, 0); PG8_LDB(B1, 0, 1); PG8_SCHED; PG8_LDA(At, 0, 0); PG8_STAGE(PG8_SA(1, 1), a1 + hstepA, voffA);
            PG8_WAIT_V(8); PG8_WAIT_L(0); PG8_BAR; PG8_MMA(0, 0, At, B0); PG8_MMA(0, 1, At, B1); PG8_BAR; PG8_SCHED;
            PG8_LDA(At, 0, 1); PG8_STAGE(PG8_SB(0, 0), b2, voffB); PG8_STAGE(PG8_SB(0, 1), b2 + hstepB, voffB); PG8_STAGE(PG8_SA(0, 0), a2, voffA);
            PG8_WAIT_V(8); PG8_WAIT_L(0); PG8_BAR; PG8_MMA(1, 0, At, B0); PG8_MMA(1, 1, At, B1); PG8_BAR; PG8_SCHED;
            PG8_LDB(B0, 1, 0); PG8_LDB(B1, 1, 1); PG8_SCHED; PG8_LDA(At, 1, 0); PG8_STAGE(PG8_SA(0, 1), a2 + hstepA, voffA);
            PG8_WAIT_V(8); PG8_WAIT_L(0); PG8_BAR; PG8_MMA(0, 0, At, B0); PG8_MMA(0, 1, At, B1); PG8_BAR; PG8_SCHED;
            PG8_LDA(At, 1, 1); PG8_STAGE(PG8_SB(1, 0), b3, voffB); PG8_STAGE(PG8_SB(1, 1), b3 + hstepB, voffB); PG8_STAGE(PG8_SA(1, 0), a3, voffA);
            PG8_WAIT_V(8); PG8_WAIT_L(0); PG8_BAR; PG8_MMA(1, 0, At, B0); PG8_MMA(1, 1, At, B1); PG8_BAR; PG8_SCHED;
        }
        if (wr == 0) PG8_BAR;
        epilogue(kind, l, acc, cur, wr, wc, fr, fq);
        __builtin_amdgcn_s_waitcnt(0x0F70);
        if (!has_next) break;
#pragma unroll
        for (int a = 0; a < 2; ++a)
#pragma unroll
            for (int b = 0; b < 2; ++b)
#pragma unroll
                for (int m = 0; m < 4; ++m)
#pragma unroll
                    for (int n = 0; n < 2; ++n) acc[a][b][m][n] = (f32x4){0.f, 0.f, 0.f, 0.f};
        cur = nxt; cA = nA; cB = nB; ++ui;
        if (wr == 1) PG8_BAR;
    }
    PG8_WAIT_V(0);
    PG8_BAR;
#undef PG8_SA
#undef PG8_SB
#undef PG8_STAGE
#undef PG8_LDA
#undef PG8_LDB
#undef PG8_MMA
#undef PG8_WAIT_V
#undef PG8_WAIT_L
#undef PG8_BAR
#undef PG8_SCHED
}

DI void mini_gemm(LAS unsigned char* lds, const GemmD g, const int kind, const int l) {
    const int tid = tid_(), wid = __builtin_amdgcn_readfirstlane(tid >> 6), lane = tid & 63, fr = lane & 15, fq = lane >> 4;
    LAS float* part = (LAS float*)lds;
    const int kw = g.K >> 3;
    for (int mu = bid_(); mu < 256; mu += gdim_()) {
        const int m0 = TP + (mu >> 4) * 32, n0 = (mu & 15) * 64;
        const bf16_t* Ab = g.A + (size_t)m0 * g.lda + (size_t)(n0 >> 8) * g.a_pn_off + wid * kw + 8 * fq;
        const bf16_t* Bb = g.Bt + (size_t)n0 * g.ldb + wid * kw + 8 * fq;
        f32x4 acc[2][4];
#pragma unroll
        for (int mb = 0; mb < 2; ++mb)
#pragma unroll
            for (int nb = 0; nb < 4; ++nb) acc[mb][nb] = (f32x4){0.f, 0.f, 0.f, 0.f};
#pragma unroll 4
        for (int k = 0; k < kw; k += 32) { bf16x8 a[2], b[4];
#pragma unroll
            for (int mb = 0; mb < 2; ++mb) a[mb] = *(const bf16x8*)(Ab + (size_t)(16 * mb + fr) * g.lda + k);
#pragma unroll
            for (int nb = 0; nb < 4; ++nb) b[nb] = *(const bf16x8*)(Bb + (size_t)(16 * nb + fr) * g.ldb + k);
#pragma unroll
            for (int mb = 0; mb < 2; ++mb)
#pragma unroll
                for (int nb = 0; nb < 4; ++nb) acc[mb][nb] = MFMA16(b[nb], a[mb], acc[mb][nb]); }
#pragma unroll
        for (int mb = 0; mb < 2; ++mb)
#pragma unroll
            for (int nb = 0; nb < 4; ++nb) *(LAS f32x4*)(part + (wid * 32 + 16 * mb + fr) * 68 + 16 * nb + 4 * fq) = acc[mb][nb];
        LDS_BARRIER();
        { const int r = tid >> 4, c4 = (tid & 15) * 4; f32x4 v = {0.f, 0.f, 0.f, 0.f};
#pragma unroll
          for (int w = 0; w < 8; ++w) v += *(const LAS f32x4*)(part + (w * 32 + r) * 68 + c4);
          const EpiD E = make_epi(kind, l, true); const int row = m0 + r, col = n0 + c4;
          if (E.mode == EM_PLAIN) { u32x2 w; w.x = pk2(v[0], v[1]); w.y = pk2(v[2], v[3]); *(u32x2*)(E.o0 + (size_t)row * DM + col) = w; }
          else { float* xp = E.x + (size_t)row * DM + col; f32x4 x0 = *(const f32x4*)(E.xin + (size_t)row * DM + col);
              if (E.mode == EM_PLE) { const float rs = rs_of(sum16(E.ss_in + (size_t)row * 16), 1.f / 1024.f); const u32x2 pw = *(const u32x2*)(E.ppb + (size_t)row * DM + col);
                  x0[0] += sigmoidf_(v[0] * rs) * bflo(pw.x) * E.alpha; x0[1] += sigmoidf_(v[1] * rs) * bfhi(pw.x) * E.alpha; x0[2] += sigmoidf_(v[2] * rs) * bflo(pw.y) * E.alpha; x0[3] += sigmoidf_(v[3] * rs) * bfhi(pw.y) * E.alpha; }
              else if (E.cs) x0 += v * *(const f32x4*)(E.cs + col) * E.alpha;
              else x0 += v * E.alpha;
              *(f32x4*)xp = x0; u32x2 w; w.x = pk2(x0[0], x0[1]); w.y = pk2(x0[2], x0[3]); *(u32x2*)(E.xb + (size_t)row * DM + col) = w;
              float sq = (x0[0] * x0[0] + x0[1] * x0[1]) + (x0[2] * x0[2] + x0[3] * x0[3]);
              sq += __shfl_xor(sq, 1); sq += __shfl_xor(sq, 2); sq += __shfl_xor(sq, 4); sq += __shfl_xor(sq, 8);
              if ((tid & 15) == 0) E.ss_out[(size_t)row * 16 + (n0 >> 6)] = sq; } }
        LDS_BARRIER();
    }
}

struct Job { const float* src; const float* scale; bf16_t* dst; int K, N, ldk, mode; };
constexpr int NJOBS = 42;
DI Job get_job(const Params& P, int j) {
    Job b; b.scale = nullptr; b.mode = 0;
    unsigned char* ws = P.ws;
    if (j < 32) { const int l = j >> 3, s = j & 7;
        if (s == 0 || s == 1 || s == 3 || s == 4) { const bool second = s >= 3; const bool up = (s == 1 || s == 4);
            b.src = P.in[second ? (up ? I_F2U : I_F2G) : (up ? I_F1U : I_F1G)] + (size_t)l * 1024 * FF; b.scale = P.in[second ? I_NF2 : I_NF1] + l * 1024;
            b.dst = (bf16_t*)(ws + (second ? O_W2 : O_W1) + (size_t)l * SZ_W1); b.K = 1024; b.N = FF; b.ldk = 1024; b.mode = up ? 2 : 1;
        } else if (s == 2 || s == 5) { const bool second = s == 5;
            b.src = P.in[second ? I_F2D : I_F1D] + (size_t)l * FF * 1024; b.dst = (bf16_t*)(ws + (second ? O_D2 : O_D1) + (size_t)l * SZ_D1); b.K = FF; b.N = 1024; b.ldk = FF;
        } else if (s == 6) { b.src = P.in[I_PLEG] + (size_t)l * 1024 * 1024; b.scale = P.in[I_NPLE] + l * 1024; b.dst = (bf16_t*)(ws + O_PG + (size_t)l * SZ_SQ); b.K = 1024; b.N = 1024; b.ldk = 1024;
        } else { b.src = P.in[I_PLEP] + (size_t)l * 256 * 1024; b.dst = (bf16_t*)(ws + O_PPW + (size_t)l * SZ_PPW); b.K = 256; b.N = 1024; b.ldk = 256; }
    } else if (j == 32) { b.src = P.in[I_GMIN]; b.scale = P.in[I_NMIX]; b.dst = (bf16_t*)(ws + O_GMIN); b.K = 1024; b.N = 2048; b.ldk = 1024;
    } else if (j == 33) { b.src = P.in[I_GMOUT]; b.dst = (bf16_t*)(ws + O_GMOUT); b.K = 1024; b.N = 1024; b.ldk = 1024;
    } else if (j < 38) { const int gi = j - 34; b.src = P.in[I_POOLW] + (size_t)gi * 65536; b.dst = (bf16_t*)(ws + O_POOLW) + (size_t)gi * 65536; b.K = 256; b.N = 256; b.ldk = 256;
    } else if (j == 38) { b.src = P.in[I_GLAIN]; b.scale = P.in[I_NMIX] + 2048; b.dst = (bf16_t*)(ws + O_GLAIN); b.K = 1024; b.N = 3072; b.ldk = 1024;
    } else if (j == 39) { b.src = P.in[I_GLAOUT]; b.dst = (bf16_t*)(ws + O_GLAOUT); b.K = 1024; b.N = 1024; b.ldk = 1024;
    } else if (j == 40) { b.src = P.in[I_SSMIN]; b.scale = P.in[I_NMIX] + 3072; b.dst = (bf16_t*)(ws + O_SSMIN); b.K = 1024; b.N = 5152; b.ldk = 1024;
    } else { b.src = P.in[I_SSMOUT]; b.scale = P.in[I_SSMNORM]; b.dst = (bf16_t*)(ws + O_SSMOUT); b.K = 2048; b.N = 1024; b.ldk = 2048; }
    return b;
}
DI void transpose_item(const Job& jb, int item, LAS float* scr, int lane) {
    const int nblk = (jb.N + 63) >> 6, kb = item / nblk, nb = item - kb * nblk, k0 = 32 * kb, n0 = 64 * nb;
    const int nl = (lane & 15) * 4, kr = lane >> 4;
    const bool ok = (n0 + nl) < jb.N;
    f32x4 v[8];
#pragma unroll
    for (int i = 0; i < 8; ++i) v[i] = ok ? __builtin_nontemporal_load((const f32x4*)(jb.src + (size_t)(k0 + 4 * i + kr) * jb.N + n0 + nl)) : (f32x4){0.f, 0.f, 0.f, 0.f};
#pragma unroll
    for (int i = 0; i < 8; ++i) { const int kk = 4 * i + kr; const float sc = jb.scale ? jb.scale[k0 + kk] : 1.f; LAS float* d = scr + kk * 65 + nl;
        d[0] = v[i][0] * sc; d[1] = v[i][1] * sc; d[2] = v[i][2] * sc; d[3] = v[i][3] * sc; }
    asm volatile("s_waitcnt lgkmcnt(0)" ::: "memory");
    const int c = lane & 3;
#pragma unroll
    for (int j = 0; j < 4; ++j) { const int n = (lane >> 2) + 16 * j; const LAS float* s = scr + (8 * c) * 65 + n;
        u32x4 o; o.x = pk2(s[0 * 65], s[1 * 65]); o.y = pk2(s[2 * 65], s[3 * 65]); o.z = pk2(s[4 * 65], s[5 * 65]); o.w = pk2(s[6 * 65], s[7 * 65]);
        const int nn = n0 + n;
        if (nn < jb.N) { const int drow = jb.mode == 0 ? nn : ((nn >> 2) * 8 + (nn & 3) + (jb.mode == 2 ? 4 : 0)); *(u32x4*)(jb.dst + (size_t)drow * jb.ldk + k0 + 8 * c) = o; } }
    asm volatile("s_waitcnt lgkmcnt(0)" ::: "memory");
}

DI void phase0(const Params& P, LAS unsigned char* lds) {
    const int tid = tid_(), wid = tid >> 6, lane = tid & 63;
    const int gw = bid_() * 8 + wid, NW = gdim_() * 8;
    const int gt = bid_() * 512 + tid, NT = gdim_() * 512;
    unsigned char* ws = P.ws;
    { float* X = (float*)(ws + O_X); bf16_t* XB = (bf16_t*)(ws + O_XB); float* ST = (float*)(ws + O_ST);
      for (int row = gw; row < T; row += NW) {
          const float* src = row < TP ? P.in[I_XP] + (size_t)row * DM : P.in[I_XS] + (size_t)(row - TP) * DM;
          float sq = 0.f;
#pragma unroll
          for (int j = 0; j < 4; ++j) { const f32x4 v = *(const f32x4*)(src + lane * 4 + 256 * j);
              u32x2 w; w.x = pk2(v[0], v[1]); w.y = pk2(v[2], v[3]); *(u32x2*)(XB + (size_t)row * DM + lane * 4 + 256 * j) = w;
              sq += (v[0] * v[0] + v[1] * v[1]) + (v[2] * v[2] + v[3] * v[3]); }
#pragma unroll
          for (int o = 32; o >= 1; o >>= 1) sq += __shfl_xor(sq, o);
          if (lane < 16) ST[(size_t)row * 16 + lane] = lane == 0 ? sq : 0.f; } }
    { bf16_t* GI = (bf16_t*)(ws + O_GLAIN); const float* a1 = P.in[I_GLAA1]; const float* g = P.in[I_NMIX] + 2048;
      for (int i = gt; i < 16 * 1024; i += NT) { const int n = i >> 10, k = i & 1023; GI[(size_t)(3072 + n) * 1024 + k] = f2bf(a1[k * 16 + n] * g[k]); }
      bf16_t* WS = (bf16_t*)(ws + O_WSB); const float* w = P.in[I_GMWS];
      for (int i = gt; i < 8 * 128 * 128; i += NT) { const int t = (i >> 7) & 127, s = i & 127; WS[i] = f2bf(s <= t ? w[i] : 0.f); } }
    { LAS float* scr = (LAS float*)lds + wid * (32 * 65);
      int start = gw;
      for (int j = 0; j < NJOBS; ++j) { const Job jb = get_job(P, j); const int n = (jb.K / 32) * ((jb.N + 63) >> 6);
          for (int it = start; it < n; it += NW) transpose_item(jb, it, scr, lane);
          start = (((start - n) % NW) + NW) % NW; } }
}

DI void conv_p(const Params& P, int l) {
    const int gt = bid_() * 512 + tid_(), NT = gdim_() * 512; bf16_t* PB = (bf16_t*)(P.ws + O_PBF);
#pragma unroll 4
    for (int i = gt; i < T * 64; i += NT) { const int row = i >> 6, c4 = (i & 63) * 4;
        const float* src = row < TP ? P.in[I_PP] + ((size_t)l * TP + row) * 256 + c4 : P.in[I_PS] + ((size_t)l * 512 + (row - TP)) * 256 + c4;
        const f32x4 v = *(const f32x4*)src; u32x2 w; w.x = pk2(v[0], v[1]); w.y = pk2(v[2], v[3]); *(u32x2*)(PB + (size_t)row * 256 + c4) = w; }
}

DI void gm_spatial(const Params& P, LAS unsigned char* lds) {
    const int tid = tid_(), wid = __builtin_amdgcn_readfirstlane(tid >> 6), lane = tid & 63, fr = lane & 15, fq = lane >> 4;
    unsigned char* ws = P.ws;
    const bf16_t* U = (const bf16_t*)(ws + O_R + R_U); const bf16_t* V = (const bf16_t*)(ws + O_R + R_V); bf16_t* GU = (bf16_t*)(ws + O_R + R_GU);
    const float* GS = (const float*)(ws + O_ST) + ST_GSP; const bf16_t* WSB = (const bf16_t*)(ws + O_WSB);
    const float* lng = P.in[I_GMLN]; const float* bs = P.in[I_GMBS];
    LAS bf16_t* Vt = (LAS bf16_t*)lds;
    for (int u = bid_(); u < 1024; u += gdim_()) {
        const int g = u & 7, row0 = (u >> 3) * 128;
        { const int s = tid & 127; const int row = row0 + s; float s1 = 0.f, s2 = 0.f;
#pragma unroll
          for (int q = 0; q < 8; ++q) { const f32x4 gq = *(const f32x4*)(GS + (size_t)row * 32 + 4 * q); s1 += gq[0] + gq[2]; s2 += gq[1] + gq[3]; }
          const float mean = s1 * (1.f / 1024.f); const float var = s2 * (1.f / 1024.f) - mean * mean; const float rstd = rsqrtf(var + EPS);
#pragma unroll
          for (int i = 0; i < 4; ++i) { const int c8 = ((tid >> 7) + 4 * i) * 8; const u32x4 w = *(const u32x4*)(V + (size_t)row * DM + g * 128 + c8); float f[8]; unpack8(w, f);
#pragma unroll
              for (int j = 0; j < 8; ++j) Vt[(c8 + j) * 136 + s] = f2bf((f[j] - mean) * rstd * lng[g * 128 + c8 + j]); } }
        LDS_BARRIER();
        f32x4 acc[8];
#pragma unroll
        for (int nb = 0; nb < 8; ++nb) acc[nb] = (f32x4){0.f, 0.f, 0.f, 0.f};
        const int nks = (wid >> 1) + 1;
        for (int ks = 0; ks < nks; ++ks) {
            const bf16x8 a = *(const bf16x8*)(WSB + (size_t)(g * 128 + 16 * wid + fr) * 128 + 32 * ks + 8 * fq);
#pragma unroll
            for (int nb = 0; nb < 8; ++nb) { const bf16x8 b = *(const LAS bf16x8*)(Vt + (16 * nb + fr) * 136 + 32 * ks + 8 * fq); acc[nb] = MFMA16(b, a, acc[nb]); } }
        { const int tl = 16 * wid + fr; const float bias = bs[g * 128 + tl]; const size_t rb = (size_t)(row0 + tl) * DM + g * 128 + 4 * fq;
#pragma unroll
          for (int nb = 0; nb < 8; ++nb) { const u32x2 uw = *(const u32x2*)(U + rb + 16 * nb); u32x2 w;
              w.x = pk2(bflo(uw.x) * (acc[nb][0] + bias), bfhi(uw.x) * (acc[nb][1] + bias)); w.y = pk2(bflo(uw.y) * (acc[nb][2] + bias), bfhi(uw.y) * (acc[nb][3] + bias));
              *(u32x2*)(GU + rb + 16 * nb) = w; } }
        LDS_BARRIER();
    }
    { const int gt = bid_() * 512 + tid, NT = gdim_() * 512; const float* wsf = P.in[I_GMWS]; float* CV = P.out + OUT_CV;
      for (int e = gt; e < 128 * 1024; e += NT) { const int b = e >> 10, c = e & 1023, g = c >> 7; float vl[4];
#pragma unroll
          for (int s = 0; s < 4; ++s) { const int row = TP + 4 * b + s; float s1 = 0.f, s2 = 0.f;
#pragma unroll
              for (int q = 0; q < 8; ++q) { const f32x4 gq = *(const f32x4*)(GS + (size_t)row * 32 + 4 * q); s1 += gq[0] + gq[2]; s2 += gq[1] + gq[3]; }
              const float mean = s1 * (1.f / 1024.f); const float var = s2 * (1.f / 1024.f) - mean * mean;
              vl[s] = (bf2f(V[(size_t)row * DM + c]) - mean) * rsqrtf(var + EPS) * lng[c]; CV[(size_t)(4 * b + s) * DM + c] = vl[s]; }
#pragma unroll
          for (int t = 0; t < 4; ++t) { float sv = bs[g * 128 + t];
#pragma unroll
              for (int s = 0; s <= t; ++s) sv += wsf[(g * 128 + t) * 128 + s] * vl[s];
              const size_t o = (size_t)(TP + 4 * b + t) * DM + c; GU[o] = f2bf(bf2f(U[o]) * sv); } } }
}

DI void pool_prep(const Params& P, LAS unsigned char* lds) {
    const int tid = tid_(); unsigned char* ws = P.ws;
    const float* X = (const float*)(ws + O_X); const float* SS = (const float*)(ws + O_ST) + (size_t)16 * T; bf16_t* DF = (bf16_t*)(ws + O_R + R_DIFF);
    const float* gm = P.in[I_NMIX] + 1024; const float* hist = P.in[I_SPOOL];
    const int sub = tid >> 8, c4 = (tid & 255) * 4, w = 2 << (c4 >> 8);
    const f32x4 g4 = *(const f32x4*)(gm + c4);
    LAS float* rsl = (LAS float*)lds + sub * 32;
    for (int it = bid_() * 2 + sub; it < 1152; it += gdim_() * 2) {
        LDS_BARRIER();
        if (it < 1024) { const int b = it >> 7, t0 = (it & 127) * 16; const size_t rb = (size_t)b * 2048; const int k = tid & 255;
            if (k < 31) { const int tt = t0 - 15 + k; rsl[k] = tt >= 0 ? rs_of(sum16(SS + (rb + tt) * 16), 1.f / 1024.f) : 0.f; } }
        LDS_BARRIER();
        if (it < 1024) { const int b = it >> 7, t0 = (it & 127) * 16; const size_t rb = (size_t)b * 2048;
            f32x4 sum = {0.f, 0.f, 0.f, 0.f};
            for (int j = 1; j < w; ++j) { const int tt = t0 - j; if (tt >= 0) { const float rs = rsl[15 - j]; sum += *(const f32x4*)(X + (rb + tt) * DM + c4) * g4 * rs; } }
#pragma unroll 8
            for (int t = t0; t < t0 + 16; ++t) { const float rs = rsl[t - t0 + 15]; const f32x4 cur = *(const f32x4*)(X + (rb + t) * DM + c4) * g4 * rs;
                sum += cur; const float ic = __builtin_amdgcn_rcpf((float)(t + 1 < w ? t + 1 : w)); const f32x4 d = sum * ic - cur;
                u32x2 o; o.x = pk2(d[0], d[1]); o.y = pk2(d[2], d[3]); *(u32x2*)(DF + (rb + t) * DM + c4) = o;
                if (t >= 2033) *(f32x4*)(P.out + OUT_POOLP + ((size_t)b * 15 + (t - 2033)) * DM + c4) = cur;
                const int tt = t - w + 1; if (tt >= 0) { const float r2 = rsl[tt - t0 + 15]; sum -= *(const f32x4*)(X + (rb + tt) * DM + c4) * g4 * r2; } }
        } else { const int b = it - 1024; const size_t rb = (size_t)TP + 4 * b; const float* hb = hist + (size_t)b * 15 * DM + c4;
            f32x4 sum = {0.f, 0.f, 0.f, 0.f}; f32x4 hc[4];
            for (int j = 1; j < w; ++j) sum += *(const f32x4*)(hb + (size_t)(15 - j) * DM);
            const float ic = 1.f / (float)w;
#pragma unroll
            for (int t = 0; t < 4; ++t) { const float rs = rs_of(sum16(SS + (rb + t) * 16), 1.f / 1024.f); const f32x4 cur = *(const f32x4*)(X + (rb + t) * DM + c4) * g4 * rs; hc[t] = cur;
                sum += cur; const f32x4 d = sum * ic - cur; u32x2 o; o.x = pk2(d[0], d[1]); o.y = pk2(d[2], d[3]); *(u32x2*)(DF + (rb + t) * DM + c4) = o;
                const int tt = t - w + 1; f32x4 old;
                if (tt >= 0) old = (tt == 0 ? hc[0] : (tt == 1 ? hc[1] : hc[2])); else old = *(const f32x4*)(hb + (size_t)(15 + tt) * DM);
                sum -= old; }
            float* po = P.out + OUT_POOLS + (size_t)b * 15 * DM + c4;
            for (int j = 0; j < 11; ++j) *(f32x4*)(po + (size_t)j * DM) = *(const f32x4*)(hb + (size_t)(4 + j) * DM);
#pragma unroll
            for (int j = 0; j < 4; ++j) *(f32x4*)(po + (size_t)(11 + j) * DM) = hc[j];
        }
    }
}

DI void gla_prep(const Params& P, LAS unsigned char* lds) {
    const int ch = tid_(); unsigned char* ws = P.ws;
    const bf16_t* QK = (const bf16_t*)(ws + O_R + R_QKVR); const float* T16 = (const float*)(ws + O_R + R_T16);
    bf16_t* QD = (bf16_t*)(ws + O_R + R_QD); bf16_t* KI = (bf16_t*)(ws + O_R + R_KI); float* DEC = (float*)(ws + O_R + R_DEC); float* SA = (float*)(ws + O_R + R_SA);
    float w2[16];
#pragma unroll
    for (int r = 0; r < 16; ++r) w2[r] = P.in[I_GLAA2][r * 512 + ch];
    const float ba = P.in[I_GLABA][ch];
    for (int it = bid_(); it < 384; it += gdim_()) {
        const bool prompt = it < 256; const int row0 = prompt ? it * 64 : TP + (it - 256) * 4; const int nt = prompt ? 64 : 4;
        float b = 0.f;
        LAS float* t16s = (LAS float*)lds;
        LDS_BARRIER();
        for (int i = ch; i < nt * 4; i += 512) *(LAS f32x4*)(t16s + 4 * i) = *(const f32x4*)(T16 + (size_t)row0 * 16 + 4 * i);
        LDS_BARRIER();
#pragma unroll 8
        for (int t = 0; t < nt; ++t) { const int row = row0 + t; float z = ba;
#pragma unroll
            for (int r4 = 0; r4 < 4; ++r4) { const f32x4 tv = *(const LAS f32x4*)(t16s + t * 16 + 4 * r4); z += tv[0] * w2[4 * r4] + tv[1] * w2[4 * r4 + 1] + tv[2] * w2[4 * r4 + 2] + tv[3] * w2[4 * r4 + 3]; }
            const float la = (fminf(z, 0.f) - __logf(1.0f + __expf(-fabsf(z)))) * (1.f / 16.f);
            if (prompt) { b += la; const float q = bf2f(QK[(size_t)row * 3072 + ch]), k = bf2f(QK[(size_t)row * 3072 + 512 + ch]);
                QD[(size_t)row * 512 + ch] = f2bf(q * __expf(b)); KI[(size_t)row * 512 + ch] = f2bf(k * __expf(-b)); }
            else SA[(size_t)(row - TP) * 512 + ch] = __expf(la); }
        if (prompt) DEC[(size_t)it * 512 + ch] = __expf(b);
    }
}

DI void gla_scan(const Params& P, LAS unsigned char* lds) {
    const int tid = tid_(), wid = __builtin_amdgcn_readfirstlane(tid >> 6), lane = tid & 63, fr = lane & 15, fq = lane >> 4;
    unsigned char* ws = P.ws;
    const bf16_t* QK = (const bf16_t*)(ws + O_R + R_QKVR); const bf16_t* QD = (const bf16_t*)(ws + O_R + R_QD); const bf16_t* KI = (const bf16_t*)(ws + O_R + R_KI);
    const float* DEC = (const float*)(ws + O_R + R_DEC); const float* SA = (const float*)(ws + O_R + R_SA); bf16_t* OB = (bf16_t*)(ws + O_R + R_OBUF);
    float* GSS = (float*)(ws + O_ST) + ST_GSSP;
    constexpr int GSET = 9216 + 4608 + 8704 + 18432;
    LAS bf16_t* St0 = (LAS bf16_t*)(lds + 9216 + 4608);
    const int mb = wid >> 1, vb = wid & 1;
    for (int it = bid_(); it < 256; it += gdim_()) {
        const int vs = it & 7, h = (it >> 3) & 3, b = it >> 5;
        f32x4 Sacc[2] = {{0.f, 0.f, 0.f, 0.f}, {0.f, 0.f, 0.f, 0.f}};
        for (int i = tid; i < 32 * 136 / 2; i += 512) ((LAS unsigned*)St0)[i] = 0u;
        u32x4 vw = {0u, 0u, 0u, 0u}, kw[2]; bf16x8 qa[4], kbf[2][4]; f32x4 dc;
#define GLA_LOAD(ROW0, NCH, QA, DC) do { \
            if (tid < 256) vw = *(const u32x4*)(QK + (size_t)((ROW0) + (tid & 63)) * 3072 + 1024 + h * 256 + vs * 32 + (tid >> 6) * 8); \
            _Pragma("unroll") for (int i_ = 0; i_ < 2; ++i_) { const int idx_ = tid + 512 * i_; kw[i_] = *(const u32x4*)(KI + (size_t)((ROW0) + (idx_ & 63)) * 512 + h * 128 + (idx_ >> 6) * 8); } \
            _Pragma("unroll") for (int ks_ = 0; ks_ < 4; ++ks_) QA[ks_] = *(const bf16x8*)(QD + (size_t)((ROW0) + 16 * mb + fr) * 512 + h * 128 + 32 * ks_ + 8 * fq); \
            _Pragma("unroll") for (int i_ = 0; i_ < 2; ++i_) _Pragma("unroll") for (int ks_ = 0; ks_ < 4; ++ks_) kbf[i_][ks_] = *(const bf16x8*)(KI + (size_t)((ROW0) + 16 * (2 * vb + i_) + fr) * 512 + h * 128 + 32 * ks_ + 8 * fq); \
            DC = *(const f32x4*)(DEC + (size_t)(NCH) * 512 + h * 128 + 16 * wid + 4 * fq); } while (0)
        GLA_LOAD(b * 2048, b * 32, qa, dc);
        for (int n = 0; n < 32; ++n) {
            const int row0 = b * 2048 + 64 * n;
            LAS unsigned char* sb_ = lds + (n & 1) * GSET; LAS unsigned char* so_ = lds + ((n & 1) ^ 1) * GSET;
            LAS bf16_t* Pm = (LAS bf16_t*)sb_; LAS bf16_t* Vt = (LAS bf16_t*)(sb_ + 9216); LAS bf16_t* St = (LAS bf16_t*)(sb_ + 13824); LAS bf16_t* KIt = (LAS bf16_t*)(sb_ + 22528);
            LAS bf16_t* Stn = (LAS bf16_t*)(so_ + 13824);
            if (tid < 256) { const int s = tid & 63, v8 = (tid >> 6) * 8; const bf16_t* e = (const bf16_t*)&vw;
#pragma unroll
                for (int j = 0; j < 8; ++j) Vt[(v8 + j) * 72 + s] = e[j]; }
#pragma unroll
            for (int i = 0; i < 2; ++i) { const int idx = tid + 512 * i, s = idx & 63, d8 = (idx >> 6) * 8; const bf16_t* e = (const bf16_t*)&kw[i];
#pragma unroll
                for (int j = 0; j < 8; ++j) KIt[(d8 + j) * 72 + s] = e[j]; }
#pragma unroll
            for (int i = 0; i < 2; ++i) { const int nb = 2 * vb + i; f32x4 sc = {0.f, 0.f, 0.f, 0.f};
#pragma unroll
                for (int ks = 0; ks < 4; ++ks) sc = MFMA16(qa[ks], kbf[i][ks], sc);
#pragma unroll
                for (int j = 0; j < 4; ++j) { const int t = 16 * mb + 4 * fq + j, s = 16 * nb + fr; Pm[t * 72 + s] = f2bf(s <= t ? sc[j] : 0.f); } }
            LDS_BARRIER();
            bf16x8 qn[4]; f32x4 dn = dc;
#pragma unroll
            for (int ks = 0; ks < 4; ++ks) qn[ks] = qa[ks];
            if (n + 1 < 32) GLA_LOAD(row0 + 64, b * 32 + n + 1, qn, dn);
            f32x4 o = {0.f, 0.f, 0.f, 0.f};
#pragma unroll
            for (int k2 = 0; k2 < 2; ++k2) { const bf16x8 a = *(const LAS bf16x8*)(Pm + (16 * mb + fr) * 72 + 32 * k2 + 8 * fq); const bf16x8 bb = *(const LAS bf16x8*)(Vt + (16 * vb + fr) * 72 + 32 * k2 + 8 * fq); o = MFMA16(a, bb, o); }
#pragma unroll
            for (int ks = 0; ks < 4; ++ks) { const bf16x8 bb = *(const LAS bf16x8*)(St + (16 * vb + fr) * 136 + 32 * ks + 8 * fq); o = MFMA16(qa[ks], bb, o); }
#pragma unroll
            for (int j = 0; j < 4; ++j) { const int row = row0 + 16 * mb + 4 * fq + j; OB[(size_t)row * DM + h * 256 + vs * 32 + 16 * vb + fr] = f2bf(o[j]); }
#pragma unroll
            for (int k2 = 0; k2 < 2; ++k2) { const bf16x8 a = *(const LAS bf16x8*)(KIt + (16 * wid + fr) * 72 + 32 * k2 + 8 * fq);
#pragma unroll
                for (int v2 = 0; v2 < 2; ++v2) { const bf16x8 bb = *(const LAS bf16x8*)(Vt + (16 * v2 + fr) * 72 + 32 * k2 + 8 * fq); Sacc[v2] = MFMA16(a, bb, Sacc[v2]); } }
            Sacc[0] *= dc; Sacc[1] *= dc;
#pragma unroll
            for (int v2 = 0; v2 < 2; ++v2) { u32x2 w; w.x = pk2(Sacc[v2][0], Sacc[v2][1]); w.y = pk2(Sacc[v2][2], Sacc[v2][3]); *(LAS u32x2*)(Stn + (16 * v2 + fr) * 136 + 16 * wid + 4 * fq) = w; }
#pragma unroll
            for (int ks = 0; ks < 4; ++ks) qa[ks] = qn[ks];
            dc = dn;
        }
#undef GLA_LOAD
        float* GO = P.out + OUT_GLAP + ((size_t)(b * 4 + h) * 128) * 256 + vs * 32;
#pragma unroll
        for (int v2 = 0; v2 < 2; ++v2)
#pragma unroll
            for (int j = 0; j < 4; ++j) GO[(size_t)(16 * wid + 4 * fq + j) * 256 + 16 * v2 + fr] = Sacc[v2][j];
        LDS_BARRIER();
    }
    LAS float* red = (LAS float*)lds;
    for (int it = bid_(); it < 512; it += gdim_()) {
        const int b = it >> 2, h = it & 3; const int v4 = lane * 4;
        const float* S0 = P.in[I_SGLA] + ((size_t)(b * 4 + h) * 128 + 16 * wid) * 256 + v4;
        f32x4 S[16];
#pragma unroll
        for (int i = 0; i < 16; ++i) S[i] = *(const f32x4*)(S0 + (size_t)i * 256);
#pragma unroll
        for (int t = 0; t < 4; ++t) { const int row = TP + 4 * b + t; const bf16_t* qk = QK + (size_t)row * 3072;
            const u32x2 vw = *(const u32x2*)(qk + 1024 + h * 256 + v4); const f32x4 v = {bflo(vw.x), bfhi(vw.x), bflo(vw.y), bfhi(vw.y)};
            f32x4 po = {0.f, 0.f, 0.f, 0.f};
            const int dl = h * 128 + 16 * wid + (lane & 15);
            const float a_l = SA[(size_t)(4 * b + t) * 512 + dl]; const float q_l = bf2f(qk[dl]), k_l = bf2f(qk[512 + dl]);
#pragma unroll
            for (int i = 0; i < 16; ++i) { const float a = __builtin_bit_cast(float, __builtin_amdgcn_readlane(__builtin_bit_cast(int, a_l), i));
                const float q = __builtin_bit_cast(float, __builtin_amdgcn_readlane(__builtin_bit_cast(int, q_l), i)), k = __builtin_bit_cast(float, __builtin_amdgcn_readlane(__builtin_bit_cast(int, k_l), i));
                S[i] = S[i] * a + v * k; po += S[i] * q; }
            *(LAS f32x4*)(red + (t * 8 + wid) * 256 + v4) = po; }
        float* SO = P.out + OUT_GLAS + ((size_t)(b * 4 + h) * 128 + 16 * wid) * 256 + v4;
#pragma unroll
        for (int i = 0; i < 16; ++i) *(f32x4*)(SO + (size_t)i * 256) = S[i];
        LDS_BARRIER();
#pragma unroll
        for (int i = 0; i < 2; ++i) { const int idx = tid + 512 * i, t = idx >> 8, v = idx & 255; float o = 0.f;
#pragma unroll
            for (int w = 0; w < 8; ++w) o += red[(t * 8 + w) * 256 + v];
            const int row = TP + 4 * b + t; OB[(size_t)row * DM + h * 256 + v] = f2bf(o); }
        LDS_BARRIER();
    }
}

DI void gla_gate(const Params& P) {
    unsigned char* ws = P.ws; const int tid = tid_(), lane = tid & 63; const int gw = bid_() * 8 + (tid >> 6), NW = gdim_() * 8;
    const bf16_t* QK = (const bf16_t*)(ws + O_R + R_QKVR); bf16_t* OB = (bf16_t*)(ws + O_R + R_OBUF); const float* gn = P.in[I_GLANORM];
    const int c16 = lane * 16;
    float g[16];
#pragma unroll
    for (int q = 0; q < 4; ++q) { const f32x4 gv = *(const f32x4*)(gn + c16 + 4 * q); g[4 * q] = gv[0]; g[4 * q + 1] = gv[1]; g[4 * q + 2] = gv[2]; g[4 * q + 3] = gv[3]; }
#pragma unroll 4
    for (int row = gw; row < T; row += NW) {
        float o[16], r[16];
        unpack8(*(const u32x4*)(OB + (size_t)row * DM + c16), o); unpack8(*(const u32x4*)(OB + (size_t)row * DM + c16 + 8), o + 8);
        unpack8(*(const u32x4*)(QK + (size_t)row * 3072 + 2048 + c16), r); unpack8(*(const u32x4*)(QK + (size_t)row * 3072 + 2048 + c16 + 8), r + 8);
        float sq = 0.f;
#pragma unroll
        for (int j = 0; j < 16; ++j) sq += o[j] * o[j];
        sq += __shfl_xor(sq, 1); sq += __shfl_xor(sq, 2); sq += __shfl_xor(sq, 4); sq += __shfl_xor(sq, 8);
        const float rs = rs_of(sq, 1.f / 256.f);
#pragma unroll
        for (int j = 0; j < 16; ++j) o[j] = o[j] * rs * g[j] * siluf_(r[j]);
        *(u32x4*)(OB + (size_t)row * DM + c16) = pack8(o); *(u32x4*)(OB + (size_t)row * DM + c16 + 8) = pack8(o + 8); }
}

DI void ssd_conv(const Params& P) {
    unsigned char* ws = P.ws; const int tid = tid_(); const int gt = bid_() * 512 + tid, NT = gdim_() * 512;
    const bf16_t* XBC = (const bf16_t*)(ws + O_R + R_XBC); bf16_t* XS = (bf16_t*)(ws + O_R + R_XBCS); const float* DTR = (const float*)(ws + O_R + R_DTR); float* DT = (float*)(ws + O_R + R_DT);
    const float* cw = P.in[I_SSMCW]; const float* cb = P.in[I_SSMCB]; const float* cs0 = P.in[I_SCONV];
    if (tid < 384) {
        const int c8 = tid * 8; float w[4][8], cbv[8];
#pragma unroll
        for (int jj = 0; jj < 4; ++jj) { const f32x4 a = *(const f32x4*)(cw + (size_t)jj * 3072 + c8), bq = *(const f32x4*)(cw + (size_t)jj * 3072 + c8 + 4);
#pragma unroll
            for (int j = 0; j < 4; ++j) { w[jj][j] = a[j]; w[jj][4 + j] = bq[j]; } }
        { const f32x4 a = *(const f32x4*)(cb + c8), bq = *(const f32x4*)(cb + c8 + 4);
#pragma unroll
          for (int j = 0; j < 4; ++j) { cbv[j] = a[j]; cbv[4 + j] = bq[j]; } }
        for (int it = bid_(); it < 640; it += gdim_()) {
            const bool prompt = it < 512; const int b = prompt ? (it >> 6) : (it - 512); const int t0 = prompt ? (it & 63) * 32 : 0; const int row0 = prompt ? it * 32 : TP + 4 * b; const int nrows = prompt ? 32 : 4;
            float h1[8], h2[8], h3[8];
            if (prompt) { if (t0 > 0) { unpack8(*(const u32x4*)(XBC + (size_t)(row0 - 1) * 3072 + c8), h1); unpack8(*(const u32x4*)(XBC + (size_t)(row0 - 2) * 3072 + c8), h2); unpack8(*(const u32x4*)(XBC + (size_t)(row0 - 3) * 3072 + c8), h3); }
                else {
#pragma unroll
                    for (int j = 0; j < 8; ++j) { h1[j] = 0.f; h2[j] = 0.f; h3[j] = 0.f; } } }
            else { const float* sp = cs0 + (size_t)b * 3 * 3072 + c8;
#pragma unroll
                for (int j = 0; j < 8; ++j) { h1[j] = sp[2 * 3072 + j]; h2[j] = sp[3072 + j]; h3[j] = sp[j]; } }
#pragma unroll 8
            for (int r = 0; r < nrows; ++r) { const int row = row0 + r, t = t0 + r; float cur[8], acc[8]; unpack8(*(const u32x4*)(XBC + (size_t)row * 3072 + c8), cur);
#pragma unroll
                for (int j = 0; j < 8; ++j) { acc[j] = siluf_(cbv[j] + w[3][j] * cur[j] + w[2][j] * h1[j] + w[1][j] * h2[j] + w[0][j] * h3[j]); h3[j] = h2[j]; h2[j] = h1[j]; h1[j] = cur[j]; }
                *(u32x4*)(XS + (size_t)row * 3072 + c8) = pack8(acc);
                if (prompt && t >= 2045) { float* o = P.out + OUT_CONVP + ((size_t)b * 3 + (t - 2045)) * 3072 + c8; *(f32x4*)o = (f32x4){cur[0], cur[1], cur[2], cur[3]}; *(f32x4*)(o + 4) = (f32x4){cur[4], cur[5], cur[6], cur[7]}; }
                if (!prompt && t >= 1) { float* o = P.out + OUT_CONVS + ((size_t)b * 3 + (t - 1)) * 3072 + c8; *(f32x4*)o = (f32x4){cur[0], cur[1], cur[2], cur[3]}; *(f32x4*)(o + 4) = (f32x4){cur[4], cur[5], cur[6], cur[7]}; } }
        }
    }
    const float* dtb = P.in[I_SSMDTB];
#pragma unroll 4
    for (int i = gt; i < T * 32; i += NT) DT[i] = softplusf_(DTR[i] + dtb[i & 31]);
}

DI void ssd_scan(const Params& P, LAS unsigned char* lds) {
    const int tid = tid_(), wid = __builtin_amdgcn_readfirstlane(tid >> 6), lane = tid & 63, fr = lane & 15, fq = lane >> 4;
    unsigned char* ws = P.ws;
    const bf16_t* XS = (const bf16_t*)(ws + O_R + R_XBCS); const bf16_t* Z = (const bf16_t*)(ws + O_R + R_Z); const float* DT = (const float*)(ws + O_R + R_DT);
    bf16_t* YB = (bf16_t*)(ws + O_R + R_YBUF); float* SSS = (float*)(ws + O_ST) + ST_SSSP;
    constexpr int SSET = 9216 + 9216 + 17408 + 18432;
    LAS bf16_t* Sb0 = (LAS bf16_t*)(lds + 18432);
    const int mb = wid >> 1, hb = wid & 1;
    for (int it = bid_(); it < 256; it += gdim_()) {
        const int h = it & 31, b = it >> 5, g = h >> 3;
        const float a = -__expf(P.in[I_SSMALOG][h]); const float dsk = P.in[I_SSMD][h];
        f32x4 Sacc[4];
#pragma unroll
        for (int i = 0; i < 4; ++i) Sacc[i] = (f32x4){0.f, 0.f, 0.f, 0.f};
        for (int i = tid; i < 64 * 136 / 2; i += 512) ((LAS unsigned*)Sb0)[i] = 0u;
        float dtv; u32x4 xw, bw[2]; bf16x8 ca[4], bbf[2][4];
#define SSD_LOAD(ROW0, DTV, CA) do { \
            DTV = DT[(size_t)((ROW0) + lane) * 32 + h]; \
            xw = *(const u32x4*)(XS + (size_t)((ROW0) + lane) * 3072 + h * 64 + wid * 8); \
            _Pragma("unroll") for (int i_ = 0; i_ < 2; ++i_) bw[i_] = *(const u32x4*)(XS + (size_t)((ROW0) + lane) * 3072 + 2048 + g * 128 + (wid + 8 * i_) * 8); \
            _Pragma("unroll") for (int ks_ = 0; ks_ < 4; ++ks_) CA[ks_] = *(const bf16x8*)(XS + (size_t)((ROW0) + 16 * mb + fr) * 3072 + 2560 + g * 128 + 32 * ks_ + 8 * fq); \
            _Pragma("unroll") for (int i_ = 0; i_ < 2; ++i_) _Pragma("unroll") for (int ks_ = 0; ks_ < 4; ++ks_) bbf[i_][ks_] = *(const bf16x8*)(XS + (size_t)((ROW0) + 16 * (2 * hb + i_) + fr) * 3072 + 2048 + g * 128 + 32 * ks_ + 8 * fq); } while (0)
        SSD_LOAD(b * 2048, dtv, ca);
        for (int n = 0; n < 32; ++n) {
            const int row0 = b * 2048 + 64 * n;
            LAS unsigned char* sb_ = lds + (n & 1) * SSET; LAS unsigned char* so_ = lds + ((n & 1) ^ 1) * SSET;
            LAS bf16_t* Pm = (LAS bf16_t*)sb_; LAS bf16_t* Xt = (LAS bf16_t*)(sb_ + 9216); LAS bf16_t* Sb = (LAS bf16_t*)(sb_ + 18432); LAS bf16_t* BWt = (LAS bf16_t*)(sb_ + 35840);
            LAS bf16_t* Sbn = (LAS bf16_t*)(so_ + 18432);
            float cum = dtv * a;
#pragma unroll
            for (int of = 1; of < 64; of <<= 1) { const float o = __shfl_up(cum, of); if (lane >= of) cum += o; }
            const float cl = __shfl(cum, 63); const float wend = __expf(cl - cum) * dtv;
            { const int p8 = wid * 8; const bf16_t* e = (const bf16_t*)&xw;
#pragma unroll
              for (int j = 0; j < 8; ++j) Xt[(p8 + j) * 72 + lane] = e[j]; }
#pragma unroll
            for (int i = 0; i < 2; ++i) { const int n8 = (wid + 8 * i) * 8; float f[8]; unpack8(bw[i], f);
#pragma unroll
                for (int j = 0; j < 8; ++j) BWt[(n8 + j) * 72 + lane] = f2bf(f[j] * wend); }
            float cumt[4];
#pragma unroll
            for (int j = 0; j < 4; ++j) cumt[j] = __shfl(cum, 16 * mb + 4 * fq + j);
#pragma unroll
            for (int i = 0; i < 2; ++i) { const int nb = 2 * hb + i; f32x4 sc = {0.f, 0.f, 0.f, 0.f};
#pragma unroll
                for (int ks = 0; ks < 4; ++ks) sc = MFMA16(ca[ks], bbf[i][ks], sc);
                const int s = 16 * nb + fr; const float cums = __shfl(cum, s), dts = __shfl(dtv, s);
#pragma unroll
                for (int j = 0; j < 4; ++j) { const int t = 16 * mb + 4 * fq + j; Pm[t * 72 + s] = f2bf(s <= t ? sc[j] * __expf(cumt[j] - cums) * dts : 0.f); } }
            LDS_BARRIER();
            float dtn = dtv; bf16x8 cn[4];
#pragma unroll
            for (int ks = 0; ks < 4; ++ks) cn[ks] = ca[ks];
            if (n + 1 < 32) SSD_LOAD(row0 + 64, dtn, cn);
            f32x4 yi[2], ye[2];
#pragma unroll
            for (int i = 0; i < 2; ++i) { yi[i] = (f32x4){0.f, 0.f, 0.f, 0.f}; ye[i] = (f32x4){0.f, 0.f, 0.f, 0.f}; }
#pragma unroll
            for (int k2 = 0; k2 < 2; ++k2) { const bf16x8 am = *(const LAS bf16x8*)(Pm + (16 * mb + fr) * 72 + 32 * k2 + 8 * fq);
#pragma unroll
                for (int i = 0; i < 2; ++i) { const bf16x8 bb = *(const LAS bf16x8*)(Xt + (16 * (2 * hb + i) + fr) * 72 + 32 * k2 + 8 * fq); yi[i] = MFMA16(am, bb, yi[i]); } }
#pragma unroll
            for (int ks = 0; ks < 4; ++ks)
#pragma unroll
                for (int i = 0; i < 2; ++i) { const bf16x8 bb = *(const LAS bf16x8*)(Sb + (16 * (2 * hb + i) + fr) * 136 + 32 * ks + 8 * fq); ye[i] = MFMA16(ca[ks], bb, ye[i]); }
#pragma unroll
            for (int j = 0; j < 4; ++j) { const int tl = 16 * mb + 4 * fq + j, row = row0 + tl; const float ec = __expf(cumt[j]);
#pragma unroll
                for (int i = 0; i < 2; ++i) { const int p = 16 * (2 * hb + i) + fr; const float xv = bf2f(Xt[p * 72 + tl]);
                    YB[(size_t)row * 2048 + h * 64 + p] = f2bf(yi[i][j] + ec * ye[i][j] + dsk * xv); } }
            { const float ecl = __expf(cl);
#pragma unroll
              for (int i = 0; i < 4; ++i) Sacc[i] *= ecl; }
#pragma unroll
            for (int k2 = 0; k2 < 2; ++k2) { const bf16x8 am = *(const LAS bf16x8*)(BWt + (16 * wid + fr) * 72 + 32 * k2 + 8 * fq);
#pragma unroll
                for (int i = 0; i < 4; ++i) { const bf16x8 bb = *(const LAS bf16x8*)(Xt + (16 * i + fr) * 72 + 32 * k2 + 8 * fq); Sacc[i] = MFMA16(am, bb, Sacc[i]); } }
#pragma unroll
            for (int i = 0; i < 4; ++i) { u32x2 w; w.x = pk2(Sacc[i][0], Sacc[i][1]); w.y = pk2(Sacc[i][2], Sacc[i][3]); *(LAS u32x2*)(Sbn + (16 * i + fr) * 136 + 16 * wid + 4 * fq) = w; }
            dtv = dtn;
#pragma unroll
            for (int ks = 0; ks < 4; ++ks) ca[ks] = cn[ks];
        }
#undef SSD_LOAD
        float* SO = P.out + OUT_SSMP + ((size_t)(b * 32 + h) * 64) * 128;
#pragma unroll
        for (int i = 0; i < 4; ++i) *(f32x4*)(SO + (size_t)(16 * i + fr) * 128 + 16 * wid + 4 * fq) = Sacc[i];
        LDS_BARRIER();
    }
    { const int gw = bid_() * 8 + wid, NW = gdim_() * 8; const int n4 = (lane & 31) * 4, ph = lane >> 5;
      for (int it = gw; it < 4096; it += NW) { const int b = it >> 5, h = it & 31, g = h >> 3;
          const float a = -__expf(P.in[I_SSMALOG][h]); const float dsk = P.in[I_SSMD][h];
          const float* S0 = P.in[I_SSSM] + ((size_t)(b * 32 + h) * 64) * 128 + n4; float* SO = P.out + OUT_SSMS + ((size_t)(b * 32 + h) * 64) * 128 + n4;
#pragma unroll
          for (int half = 0; half < 2; ++half) { f32x4 S[16];
#pragma unroll
              for (int i = 0; i < 16; ++i) S[i] = *(const f32x4*)(S0 + (size_t)(ph + 2 * (16 * half + i)) * 128);
#pragma unroll 1
              for (int t = 0; t < 4; ++t) { const int row = TP + 4 * b + t; const float dtv = DT[(size_t)row * 32 + h]; const float dec = __expf(dtv * a);
                  const u32x2 bw = *(const u32x2*)(XS + (size_t)row * 3072 + 2048 + g * 128 + n4), cw2 = *(const u32x2*)(XS + (size_t)row * 3072 + 2560 + g * 128 + n4);
                  const f32x4 Bv = {bflo(bw.x), bfhi(bw.x), bflo(bw.y), bfhi(bw.y)}, Cv = {bflo(cw2.x), bfhi(cw2.x), bflo(cw2.y), bfhi(cw2.y)}; float ysel = 0.f;
#pragma unroll
                  for (int i = 0; i < 16; ++i) { const int p = ph + 2 * (16 * half + i); const float xv = bf2f(XS[(size_t)row * 3072 + h * 64 + p]);
                      S[i] = S[i] * dec + Bv * (dtv * xv);
                      float yp = (S[i][0] * Cv[0] + S[i][1] * Cv[1]) + (S[i][2] * Cv[2] + S[i][3] * Cv[3]);
                      yp += __shfl_xor(yp, 1); yp += __shfl_xor(yp, 2); yp += __shfl_xor(yp, 4); yp += __shfl_xor(yp, 8); yp += __shfl_xor(yp, 16);
                      ysel = ((lane & 31) == i) ? yp : ysel; }
                  if ((lane & 31) < 16) { const int p = ph + 2 * (16 * half + (lane & 31)); const float xv = bf2f(XS[(size_t)row * 3072 + h * 64 + p]);
                      YB[(size_t)row * 2048 + h * 64 + p] = f2bf(ysel + dsk * xv); } }
#pragma unroll
              for (int i = 0; i < 16; ++i) *(f32x4*)(SO + (size_t)(ph + 2 * (16 * half + i)) * 128) = S[i]; } } }
}

DI void ssd_norm(const Params& P) {
    unsigned char* ws = P.ws; const int tid = tid_(), lane = tid & 63; const int gw = bid_() * 8 + (tid >> 6), NW = gdim_() * 8;
    bf16_t* YB = (bf16_t*)(ws + O_R + R_YBUF); const bf16_t* Z = (const bf16_t*)(ws + O_R + R_Z);
#pragma unroll 4
    for (int item = gw; item < T * 4; item += NW) { const size_t off = (size_t)(item >> 2) * 2048 + (item & 3) * 512 + lane * 8;
        const u32x4 yw = *(const u32x4*)(YB + off), zw = *(const u32x4*)(Z + off); float f[8], z[8]; unpack8(yw, f); unpack8(zw, z);
        float sq = 0.f;
#pragma unroll
        for (int j = 0; j < 8; ++j) { f[j] *= siluf_(z[j]); sq += f[j] * f[j]; }
#pragma unroll
        for (int o = 32; o >= 1; o >>= 1) sq += __shfl_xor(sq, o);
        const float rs = rs_of(sq, 1.f / 512.f);
#pragma unroll
        for (int j = 0; j < 8; ++j) f[j] *= rs;
        *(u32x4*)(YB + off) = pack8(f); }
}

DI void final_norm(const Params& P) {
    unsigned char* ws = P.ws; const int gt = bid_() * 512 + tid_(), NT = gdim_() * 512;
    const float* X = (const float*)(ws + O_X); const float* SS = (const float*)(ws + O_ST); const float* g = P.in[I_NFIN];
#pragma unroll 4
    for (int i = gt; i < T * 256; i += NT) { const int row = i >> 8, c4 = (i & 255) * 4; const float rs = rs_of(sum16(SS + (size_t)row * 16), 1.f / 1024.f);
        const f32x4 v = *(const f32x4*)(X + (size_t)row * DM + c4) * *(const f32x4*)(g + c4) * rs; *(f32x4*)(P.out + OUT_Y + (size_t)row * DM + c4) = v; }
}

__constant__ unsigned char PH_KIND[NPHASES] = { K_P0,
    K_A, K_B, K_GM1, K_GM2, K_GM3, K_D, K_E, K_PP, K_F,
    K_A, K_B, K_PL1, K_PL2, K_D, K_E, K_PP, K_F,
    K_A, K_B, K_GL1, K_GL2, K_GL3, K_GL4, K_GL5, K_D, K_E, K_PP, K_F,
    K_A, K_B, K_SS1, K_SS2, K_SS3, K_SS4, K_SS5, K_D, K_E, K_PP, K_F,
    K_FIN };
__constant__ unsigned char PH_LAYER[NPHASES] = { 0, 0, 0, 0, 0, 0, 0, 0, 0, 0, 1, 1, 1, 1, 1, 1, 1, 1, 2, 2, 2, 2, 2, 2, 2, 2, 2, 2, 2, 3, 3, 3, 3, 3, 3, 3, 3, 3, 3, 3, 3 };

DI void run_phase(const Params& P, int ph, LAS unsigned char* lds) {
    const int kind = PH_KIND[ph], l = PH_LAYER[ph]; unsigned char* ws = P.ws;
    GemmD g; bool is_gemm = true;
    g.A = (const bf16_t*)(ws + O_XB); g.lda = 1024; g.ldb = 1024; g.a_pn_off = 0; g.nM = 66; g.nN = 4; g.K = 1024; g.Bt = nullptr;
    switch (kind) {
    case K_A: case K_D: g.Bt = (const bf16_t*)(ws + (kind == K_A ? O_W1 : O_W2) + (size_t)l * SZ_W1); g.nN = 22; if (kind == K_A && l > 0) g.A = (const bf16_t*)(ws + O_XB2); break;
    case K_B: case K_E: g.A = (const bf16_t*)(ws + O_R + R_ACT); g.lda = FF; g.ldb = FF; g.K = FF; g.Bt = (const bf16_t*)(ws + (kind == K_B ? O_D1 : O_D2) + (size_t)l * SZ_D1); break;
    case K_PP: g.A = (const bf16_t*)(ws + O_PBF); g.lda = 256; g.ldb = 256; g.K = 256; g.Bt = (const bf16_t*)(ws + O_PPW + (size_t)l * SZ_PPW); break;
    case K_F: g.Bt = (const bf16_t*)(ws + O_PG + (size_t)l * SZ_SQ); break;
    case K_GM1: g.Bt = (const bf16_t*)(ws + O_GMIN); g.nN = 8; break;
    case K_GM3: g.A = (const bf16_t*)(ws + O_R + R_GU); g.Bt = (const bf16_t*)(ws + O_GMOUT); break;
    case K_PL2: g.A = (const bf16_t*)(ws + O_R + R_DIFF); g.a_pn_off = 256; g.ldb = 256; g.K = 256; g.Bt = (const bf16_t*)(ws + O_POOLW); break;
    case K_GL1: g.Bt = (const bf16_t*)(ws + O_GLAIN); g.nN = 13; break;
    case K_GL5: g.A = (const bf16_t*)(ws + O_R + R_OBUF); g.Bt = (const bf16_t*)(ws + O_GLAOUT); break;
    case K_SS1: g.Bt = (const bf16_t*)(ws + O_SSMIN); g.nN = 21; break;
    case K_SS5: g.A = (const bf16_t*)(ws + O_R + R_YBUF); g.lda = 2048; g.ldb = 2048; g.K = 2048; g.Bt = (const bf16_t*)(ws + O_SSMOUT); break;
    default: is_gemm = false; break;
    }
    if (is_gemm) {
        const bool mini = (g.nN == 4);
        if (mini) g.nM = 64;
        gemm_phase(lds, g, kind, l);
        if (mini) mini_gemm(lds, g, kind, l);
        if (kind == K_A) conv_p(fresh_params(), l);
        return; }
    switch (kind) {
    case K_P0: phase0(P, lds); break;
    case K_GM2: gm_spatial(P, lds); break;
    case K_PL1: pool_prep(P, lds); break;
    case K_GL2: gla_prep(P, lds); break;
    case K_GL3: gla_scan(P, lds); break;
    case K_GL4: gla_gate(P); break;
    case K_SS2: ssd_conv(P); break;
    case K_SS3: ssd_scan(P, lds); break;
    case K_SS4: ssd_norm(P); break;
    case K_FIN: final_norm(P); break;
    default: break;
    }
}


#define XB_TMO      128
#define XB_XCNT(j)  (256  + 64 * (j))
#define XB_XSUB(j)  (1280 + 64 * (j))
#define XB_XGEN(j)  (2304 + 64 * (j))
#define XB_TOP      3328
#define XB_TOPGEN   3392
#define XCD_BAR_WORDS 3456
#define XB_SPIN_CAP (1u << 18)
__device__ __forceinline__ unsigned xb_ld(unsigned* p)              { return __hip_atomic_load(p, __ATOMIC_RELAXED, __HIP_MEMORY_SCOPE_AGENT); }
__device__ __forceinline__ unsigned xb_add(unsigned* p, unsigned v) { return __hip_atomic_fetch_add(p, v, __ATOMIC_RELAXED, __HIP_MEMORY_SCOPE_AGENT); }
__device__ __forceinline__ unsigned xb_xcc_id() { return (unsigned)__builtin_amdgcn_s_getreg((3 << 11) | 20) & 0xFu; }
#define XB_SPIN(cond, bar) do { unsigned _sp = 0; while (cond) { __builtin_amdgcn_s_sleep(1); \
    if ((++_sp & 255u) == 0u) { if (xb_ld(&(bar)[XB_TMO])) break; if (_sp > XB_SPIN_CAP) { atomicAdd(&(bar)[XB_TMO], 1u); break; } } } } while (0)
struct XcdBarrier { unsigned* bar; unsigned x; volatile LAS unsigned* st; };
__device__ __forceinline__ XcdBarrier xcd_barrier_post(unsigned* bar, volatile LAS unsigned* st) {
    XcdBarrier b; b.bar = bar; b.x = xb_xcc_id(); b.st = st;
    if (threadIdx.x == 0) (void)xb_add(&bar[XB_XCNT(b.x)], 1u);
    return b;
}
__device__ __forceinline__ void xcd_barrier_complete(unsigned* bar, unsigned x, unsigned& nloc, unsigned& nx) {
    const unsigned G = gridDim.x * gridDim.y * gridDim.z;
    unsigned sum, cnt, mine, sp = 0u;
    for (;;) {
        sum = 0u; cnt = 0u; mine = 0u;
#pragma unroll
        for (unsigned j = 0; j < 16; ++j) { const unsigned c = xb_ld(&bar[XB_XCNT(j)]); sum += c; cnt += (c > 0u) ? 1u : 0u; mine = (j == x) ? c : mine; }
        if (sum == G) break;
        __builtin_amdgcn_s_sleep(1);
        if ((++sp & 255u) == 0u) { if (xb_ld(&bar[XB_TMO])) break; if (sp > XB_SPIN_CAP) { atomicAdd(&bar[XB_TMO], 1u); break; } }
    }
    nloc = mine > 0u ? mine : 1u; nx = cnt > 0u ? cnt : 1u;
}
__device__ __forceinline__ void xcd_barrier(const XcdBarrier& b) {
    asm volatile("s_waitcnt vmcnt(0)" ::: "memory");
    __syncthreads();
    if (threadIdx.x == 0) {
        unsigned* bar = b.bar;
        __builtin_amdgcn_s_waitcnt(0);
        unsigned nloc = b.st[0], nx = b.st[1];
        if (nloc == 0u) { xcd_barrier_complete(bar, b.x, nloc, nx); b.st[0] = nloc; b.st[1] = nx; }
        const unsigned old = xb_add(&bar[XB_XSUB(b.x)], 1u);
        const unsigned gen = old / nloc;
        if (old + 1u == (gen + 1u) * nloc) {
            __builtin_amdgcn_fence(__ATOMIC_RELEASE, "agent");
            asm volatile("s_waitcnt vmcnt(0)" ::: "memory");
            const unsigned og = xb_add(&bar[XB_TOP], 1u);
            const unsigned tg = og / nx;
            if (og + 1u == (tg + 1u) * nx) xb_add(&bar[XB_TOPGEN], 1u);
            else XB_SPIN(xb_ld(&bar[XB_TOPGEN]) == tg, bar);
            __builtin_amdgcn_fence(__ATOMIC_ACQUIRE, "agent");
            xb_add(&bar[XB_XGEN(b.x)], 1u);
            asm volatile("s_waitcnt vmcnt(0)" ::: "memory");
        } else {
            XB_SPIN(xb_ld(&bar[XB_XGEN(b.x)]) == gen, bar);
            __builtin_amdgcn_fence(__ATOMIC_ACQUIRE, "agent");
            asm volatile("s_waitcnt vmcnt(0)" ::: "memory");
        }
    }
    __syncthreads();
}

__global__ void __launch_bounds__(512, 2) mega(Params P, int ph_lo, int ph_hi) {
    extern __shared__ __attribute__((aligned(16))) unsigned char smem[];
    LAS unsigned char* lds = (LAS unsigned char*)smem;
    if (ph_lo > ph_hi) cg::this_grid().sync();
    volatile LAS unsigned* st = (volatile LAS unsigned*)(lds + 131072);
    if (threadIdx.x < 2) st[threadIdx.x] = 0u;
    __syncthreads();
    const XcdBarrier bar = xcd_barrier_post((unsigned*)(P.ws + O_BAR), st);
    for (int ph = ph_lo; ph < ph_hi; ++ph) {
        if (ph > ph_lo) xcd_barrier(bar);
        run_phase(fresh_params(), ph, lds);
    }
}

constexpr int LDS_BYTES = 131072 + 16;

extern "C" void kernel_launch(void* const* d_in, const int* in_sizes, int n_in, void* d_out, int out_size, void* d_ws, size_t ws_size, hipStream_t stream) {
    static int grid = 0;
    if (grid == 0) {
        if (n_in != N_IN || ws_size < WS_TOTAL) { fprintf(stderr, "kernel_launch: n_in %d (want %d), ws %zu (want >= %zu)\n", n_in, (int)N_IN, ws_size, (size_t)WS_TOTAL); grid = -1; return; }
        int dev = 0, cus = 0, per_cu = 0;
        hipGetDevice(&dev); hipDeviceGetAttribute(&cus, hipDeviceAttributeMultiprocessorCount, dev);
        if (hipFuncSetAttribute((const void*)mega, hipFuncAttributeMaxDynamicSharedMemorySize, LDS_BYTES) != hipSuccess) { fprintf(stderr, "kernel_launch: hipFuncSetAttribute failed\n"); grid = -1; return; }
        if (hipOccupancyMaxActiveBlocksPerMultiprocessor(&per_cu, (const void*)mega, 512, LDS_BYTES) != hipSuccess || per_cu < 1) { fprintf(stderr, "kernel_launch: occupancy query says %d\n", per_cu); per_cu = 1; }
        (void)hipGetLastError();
        grid = cus;
    }
    if (grid < 0) return;
    if (hipMemsetAsync((char*)d_ws + O_BAR, 0, 16384, stream) != hipSuccess) { fprintf(stderr, "kernel_launch: memset of the barrier words failed\n"); return; }
    Params p{};
    for (int i = 0; i < N_IN; ++i) p.in[i] = (const float*)d_in[i];
    p.out = (float*)d_out; p.ws = (unsigned char*)d_ws;
    int lo = 0, hi = NPHASES;
    void* args[] = {&p, &lo, &hi};
    hipError_t e = hipLaunchCooperativeKernel((const void*)mega, dim3(grid), dim3(512), args, LDS_BYTES, stream);
    if (e != hipSuccess) fprintf(stderr, "kernel_launch: cooperative launch failed: %s (grid %d)\n", hipGetErrorString(e), grid);
}
```

```cpp
#include <hip/hip_runtime.h>
#include <hip/hip_cooperative_groups.h>
#include <cstdio>
#include <cstdint>
namespace cg = cooperative_groups;

#define LAS __attribute__((address_space(3)))
#define DI __device__ __forceinline__
typedef unsigned short bf16_t;
typedef short bf16x8 __attribute__((ext_vector_type(8)));
typedef float f32x4 __attribute__((ext_vector_type(4)));
typedef unsigned u32x4 __attribute__((ext_vector_type(4)));
typedef unsigned u32x2 __attribute__((ext_vector_type(2)));

constexpr int T = 16896, TP = 16384, DM = 1024, FF = 2816;
constexpr float EPS = 1e-6f;
constexpr int NPHASES = 41;

constexpr size_t SZ_W1 = (size_t)5632 * 1024 * 2, SZ_D1 = (size_t)1024 * 2816 * 2, SZ_SQ = (size_t)1024 * 1024 * 2, SZ_PPW = (size_t)1024 * 256 * 2;
constexpr size_t O_W1 = 0;
constexpr size_t O_D1 = O_W1 + 4 * SZ_W1;
constexpr size_t O_W2 = O_D1 + 4 * SZ_D1;
constexpr size_t O_D2 = O_W2 + 4 * SZ_W1;
constexpr size_t O_PG = O_D2 + 4 * SZ_D1;
constexpr size_t O_PPW = O_PG + 4 * SZ_SQ;
constexpr size_t O_GMIN = O_PPW + 4 * SZ_PPW;
constexpr size_t O_GMOUT = O_GMIN + (size_t)2048 * 1024 * 2;
constexpr size_t O_POOLW = O_GMOUT + SZ_SQ;
constexpr size_t O_GLAIN = O_POOLW + (size_t)1024 * 256 * 2;
constexpr size_t O_GLAOUT = O_GLAIN + (size_t)3328 * 1024 * 2;
constexpr size_t O_SSMIN = O_GLAOUT + SZ_SQ;
constexpr size_t O_SSMOUT = O_SSMIN + (size_t)5376 * 1024 * 2;
constexpr size_t O_WSB = O_SSMOUT + (size_t)1024 * 2048 * 2;
constexpr size_t O_X = O_WSB + (size_t)8 * 128 * 128 * 2;
constexpr size_t O_XB = O_X + (size_t)T * 1024 * 4;
constexpr size_t O_ST = O_XB + (size_t)T * 1024 * 2;
constexpr size_t O_PBF = O_ST + (size_t)192 * T * 4;
constexpr size_t ST_GSP = (size_t)32 * T, ST_GSSP = (size_t)64 * T, ST_SSSP = (size_t)128 * T;
constexpr size_t O_PP = O_PBF + (size_t)T * 256 * 2;
constexpr size_t O_XB2 = O_PP + (size_t)T * 1024 * 2;
constexpr size_t O_R = O_XB2 + (size_t)T * 1024 * 2;
constexpr size_t R_ACT = 0;
constexpr size_t R_U = 0, R_V = R_U + (size_t)T * 1024 * 2, R_GU = R_V + (size_t)T * 1024 * 2;
constexpr size_t R_DIFF = 0;
constexpr size_t R_QKVR = 0, R_T16 = R_QKVR + (size_t)T * 3072 * 2, R_QD = R_T16 + (size_t)T * 16 * 4, R_KI = R_QD + (size_t)T * 512 * 2,
                 R_DEC = R_KI + (size_t)T * 512 * 2, R_SA = R_DEC + (size_t)256 * 512 * 4, R_OBUF = R_SA + (size_t)512 * 512 * 4;
constexpr size_t R_Z = 0, R_XBC = R_Z + (size_t)T * 2048 * 2, R_XBCS = R_XBC + (size_t)T * 3072 * 2, R_DTR = R_XBCS + (size_t)T * 3072 * 2,
                 R_DT = R_DTR + (size_t)T * 32 * 4, R_END = R_DT + (size_t)T * 32 * 4;
constexpr size_t R_YBUF = R_XBC;
constexpr size_t O_BAR = O_R + R_END;
constexpr size_t WS_TOTAL = O_BAR + 16384;
constexpr size_t OUT_Y = 0, OUT_CV = 17301504, OUT_POOLP = 17825792, OUT_POOLS = 17948672, OUT_GLAP = 19914752, OUT_GLAS = 20963328,
                 OUT_SSMP = 37740544, OUT_SSMS = 39837696, OUT_CONVP = 73392128, OUT_CONVS = 73465856;

enum { I_XP = 0, I_XS, I_SPOOL, I_SGLA, I_SSSM, I_SCONV, I_PP, I_PS, I_NF1, I_F1G, I_F1U, I_F1D, I_NMIX, I_NF2, I_F2G, I_F2U, I_F2D, I_NPLE, I_PLEG, I_PLEP,
       I_NFIN, I_GMIN, I_GMLN, I_GMWS, I_GMBS, I_GMOUT, I_POOLW, I_POOLSC, I_GLAIN, I_GLAA1, I_GLAA2, I_GLABA, I_GLANORM, I_GLAOUT, I_SSMIN, I_SSMCW, I_SSMCB,
       I_SSMDTB, I_SSMALOG, I_SSMD, I_SSMNORM, I_SSMOUT, N_IN };

struct Params { const float* in[N_IN]; float* out; unsigned char* ws; };
__device__ __forceinline__ const Params& fresh_params() {
    auto kp = __builtin_amdgcn_kernarg_segment_ptr();
    asm volatile("" : "+s"(kp));
    return *(const Params*)kp;
}

__device__ __forceinline__ int tid_() { int t = (int)threadIdx.x; asm volatile("" : "+v"(t)); return t & 511; }
__device__ __forceinline__ int bid_() { int b = (int)blockIdx.x; asm volatile("" : "+s"(b)); return b; }
__device__ __forceinline__ int gdim_() { int g = (int)gridDim.x; asm volatile("" : "+s"(g)); return g; }
typedef float f32x2v __attribute__((ext_vector_type(2)));
typedef __bf16 bf16x2v __attribute__((ext_vector_type(2)));
DI unsigned pk2(float lo, float hi) { const f32x2v v = {lo, hi}; const bf16x2v b = __builtin_convertvector(v, bf16x2v); return __builtin_bit_cast(unsigned, b); }
DI float bflo(unsigned w) { return __uint_as_float(w << 16); }
DI float bfhi(unsigned w) { return __uint_as_float(w & 0xffff0000u); }
DI float bf2f(bf16_t b) { return __uint_as_float(((unsigned)b) << 16); }
DI bf16_t f2bf(float f) { return (bf16_t)(pk2(f, 0.f) & 0xffffu); }
DI float sigmoidf_(float x) { return __builtin_amdgcn_rcpf(1.0f + __expf(-x)); }
DI float siluf_(float x) { return x * sigmoidf_(x); }
DI float geluf_(float x) { return x * sigmoidf_(1.5957691216f * (x + 0.044715f * x * x * x)); }
DI float softplusf_(float x) { return fmaxf(x, 0.f) + __logf(1.0f + __expf(-fabsf(x))); }
DI void unpack8(const u32x4& w, float* f) { f[0] = bflo(w.x); f[1] = bfhi(w.x); f[2] = bflo(w.y); f[3] = bfhi(w.y); f[4] = bflo(w.z); f[5] = bfhi(w.z); f[6] = bflo(w.w); f[7] = bfhi(w.w); }
DI u32x4 pack8(const float* f) { u32x4 w; w.x = pk2(f[0], f[1]); w.y = pk2(f[2], f[3]); w.z = pk2(f[4], f[5]); w.w = pk2(f[6], f[7]); return w; }
DI float rs_of(float ss, float inv_n) { return __builtin_amdgcn_rsqf(ss * inv_n + EPS); }
DI void atomic_add_f32(float* p, float v) {
    [[clang::atomic(no_remote_memory, no_fine_grained_memory, ignore_denormal_mode)]] { (void)__hip_atomic_fetch_add(p, v, __ATOMIC_RELAXED, __HIP_MEMORY_SCOPE_AGENT); }
}
DI float sum16(const float* p) { const f32x4 a = *(const f32x4*)p, b = *(const f32x4*)(p + 4), c = *(const f32x4*)(p + 8), d = *(const f32x4*)(p + 12); const f32x4 s = (a + b) + (c + d); return (s[0] + s[1]) + (s[2] + s[3]); }
#define LDS_BARRIER() do { asm volatile("s_waitcnt lgkmcnt(0)" ::: "memory"); __builtin_amdgcn_s_barrier(); asm volatile("" ::: "memory"); } while (0)
DI float sum16_fq(const float* p, int fq) { const f32x4 a = *(const f32x4*)(p + 4 * fq); float s = (a[0] + a[1]) + (a[2] + a[3]); s += __shfl_xor(s, 16); s += __shfl_xor(s, 32); return s; }
#define MFMA16(a, b, c) __builtin_amdgcn_mfma_f32_16x16x32_bf16((a), (b), (c), 0, 0, 0)

constexpr int BM = 256, BK = 64, HALF = 128, HTB = HALF * BK * 2;
DI int lds_byte(int r, int c) { const int st = (r >> 4) * 2 + (c >> 5), rr = r & 15, cc = c & 31, ob = rr * 64 + cc * 2; return st * 1024 + (ob ^ (((ob >> 9) & 1) << 5)); }
DI void stage_rc(int b, int& R, int& C) { const int st = b / 1024, sb = b % 1024, swz = sb ^ (((sb >> 9) & 1) << 5); R = (st >> 1) * 16 + swz / 64; C = (st & 1) * 32 + (swz % 64) / 2; }
DI int perm32(int rho) { const int n = rho >> 4, i = rho & 15; return 8 * (i >> 2) + 4 * n + (i & 3); }

enum { K_P0 = 0, K_A, K_B, K_D, K_E, K_PP, K_F, K_GM1, K_GM2, K_GM3, K_PL1, K_PL2, K_GL1, K_GL2, K_GL3, K_GL4, K_GL5, K_SS1, K_SS2, K_SS3, K_SS4, K_SS5, K_FIN, K_NOP };
struct Unit { int pm, pn; };
struct GemmD { const bf16_t* A; const bf16_t* Bt; int lda, ldb, a_pn_off, nM, nN, K; };
enum { EM_SWIGLU = 0, EM_RESID, EM_PLE, EM_PLAIN, EM_GMIN, EM_GLAIN, EM_SSMIN };
struct EpiD { int mode; float alpha; const float* xin; float* x; bf16_t* xb; const float* ss_in; float* ss_out; bf16_t* o0; bf16_t* o1; float* f0; const float* cs; const bf16_t* ppb; };

DI bool unit_at(const GemmD& g, int i, int G, int c, Unit& u) {
    const int nwg = g.nM * g.nN; const long L = (long)i * G + c; if (L >= nwg) return false;
    int wgid = (int)L; { const int q = nwg / 8, r = nwg % 8, xcd = wgid % 8, off = wgid / 8; wgid = (xcd < r ? xcd * (q + 1) : r * (q + 1) + (xcd - r) * q) + off; }
    const int nig = 8 * g.nN, gid = wgid / nig, fm = gid * 8, gsz = (g.nM - fm) < 8 ? (g.nM - fm) : 8;
    u.pm = fm + ((wgid % nig) % gsz); u.pn = (wgid % nig) / gsz; return true;
}

DI EpiD make_epi(int kind, int l, bool mini = false);
DI void epilogue(int kind, int l, const f32x4 (&acc)[2][2][4][2], const Unit& u, int wr, int wc, int fr, int fq) {
    const EpiD E = make_epi(kind, l);
    const int row0 = u.pm * BM + wr * 64 + fr, col0 = u.pn * BM + wc * 32 + 8 * fq;
    if (E.mode == EM_SWIGLU) {
#pragma unroll
        for (int ai = 0; ai < 2; ++ai)
#pragma unroll
            for (int m = 0; m < 4; ++m) { const int row = row0 + ai * HALF + m * 16; const float rs = rs_of(sum16_fq(E.ss_in + (size_t)row * 16, fq), 1.f / 1024.f);
#pragma unroll
                for (int bj = 0; bj < 2; ++bj) { const f32x4 g = acc[ai][bj][m][0] * rs, up = acc[ai][bj][m][1] * rs;
                    u32x2 w; w.x = pk2(siluf_(g[0]) * up[0], siluf_(g[1]) * up[1]); w.y = pk2(siluf_(g[2]) * up[2], siluf_(g[3]) * up[3]);
                    *(u32x2*)(E.o0 + (size_t)row * FF + ((col0 + bj * HALF) >> 1)) = w; } }
    } else if (E.mode == EM_RESID || E.mode == EM_PLE) {
        const bool ple = E.mode == EM_PLE;
#pragma unroll
        for (int ai = 0; ai < 2; ++ai)
#pragma unroll
            for (int m = 0; m < 4; ++m) { const int row = row0 + ai * HALF + m * 16; float sq = 0.f;
                const float rs = ple ? rs_of(sum16_fq(E.ss_in + (size_t)row * 16, fq), 1.f / 1024.f) : 0.f;
#pragma unroll
                for (int bj = 0; bj < 2; ++bj) { const int col = col0 + bj * HALF; float* xp = E.x + (size_t)row * DM + col; const float* xi = E.xin + (size_t)row * DM + col;
                    f32x4 x0 = *(const f32x4*)xi, x1 = *(const f32x4*)(xi + 4); f32x4 v0 = acc[ai][bj][m][0], v1 = acc[ai][bj][m][1];
                    if (ple) { const u32x4 pw = *(const u32x4*)(E.ppb + (size_t)row * DM + col); float pf[8]; unpack8(pw, pf);
#pragma unroll
                        for (int j = 0; j < 4; ++j) { x0[j] += sigmoidf_(v0[j] * rs) * pf[j] * E.alpha; x1[j] += sigmoidf_(v1[j] * rs) * pf[4 + j] * E.alpha; }
                    } else if (E.cs) { const f32x4 c0 = *(const f32x4*)(E.cs + col), c1 = *(const f32x4*)(E.cs + col + 4); x0 += v0 * c0 * E.alpha; x1 += v1 * c1 * E.alpha; }
                    else { x0 += v0 * E.alpha; x1 += v1 * E.alpha; }
                    *(f32x4*)xp = x0; *(f32x4*)(xp + 4) = x1;
                    u32x4 w; w.x = pk2(x0[0], x0[1]); w.y = pk2(x0[2], x0[3]); w.z = pk2(x1[0], x1[1]); w.w = pk2(x1[2], x1[3]);
                    *(u32x4*)(E.xb + (size_t)row * DM + col) = w;
                    sq += (x0[0] * x0[0] + x0[1] * x0[1]) + (x0[2] * x0[2] + x0[3] * x0[3]) + (x1[0] * x1[0] + x1[1] * x1[1]) + (x1[2] * x1[2] + x1[3] * x1[3]); }
                sq += __shfl_xor(sq, 16); sq += __shfl_xor(sq, 32);
                if (fq == 0) E.ss_out[(size_t)row * 16 + u.pn * 4 + wc] = sq; }
    } else if (E.mode == EM_PLAIN) {
#pragma unroll
        for (int ai = 0; ai < 2; ++ai)
#pragma unroll
            for (int m = 0; m < 4; ++m) { const int row = row0 + ai * HALF + m * 16;
#pragma unroll
                for (int bj = 0; bj < 2; ++bj) { const f32x4 v0 = acc[ai][bj][m][0], v1 = acc[ai][bj][m][1];
                    u32x4 w; w.x = pk2(v0[0], v0[1]); w.y = pk2(v0[2], v0[3]); w.z = pk2(v1[0], v1[1]); w.w = pk2(v1[2], v1[3]);
                    *(u32x4*)(E.o0 + (size_t)row * DM + col0 + bj * HALF) = w; } }
    } else if (E.mode == EM_GMIN) {
        const bool isv = u.pn >= 4;
#pragma unroll
        for (int ai = 0; ai < 2; ++ai)
#pragma unroll
            for (int m = 0; m < 4; ++m) { const int row = row0 + ai * HALF + m * 16; const float rs = rs_of(sum16_fq(E.ss_in + (size_t)row * 16, fq), 1.f / 1024.f); float s1 = 0.f, s2 = 0.f;
#pragma unroll
                for (int bj = 0; bj < 2; ++bj) { const int col = col0 + bj * HALF; float v[8];
#pragma unroll
                    for (int j = 0; j < 4; ++j) { v[j] = geluf_(acc[ai][bj][m][0][j] * rs); v[4 + j] = geluf_(acc[ai][bj][m][1][j] * rs); }
                    const u32x4 w = pack8(v);
                    if (isv) { *(u32x4*)(E.o1 + (size_t)row * DM + col - 1024) = w;
#pragma unroll
                        for (int j = 0; j < 8; ++j) { s1 += v[j]; s2 += v[j] * v[j]; } }
                    else *(u32x4*)(E.o0 + (size_t)row * DM + col) = w; }
                if (isv) { s1 += __shfl_xor(s1, 16); s1 += __shfl_xor(s1, 32); s2 += __shfl_xor(s2, 16); s2 += __shfl_xor(s2, 32);
                    if (fq == 0) { float* gp = E.f0 + (size_t)row * 32 + ((u.pn - 4) * 4 + wc) * 2; gp[0] = s1; gp[1] = s2; } } }
    } else if (E.mode == EM_GLAIN) {
#pragma unroll
        for (int ai = 0; ai < 2; ++ai)
#pragma unroll
            for (int m = 0; m < 4; ++m) { const int row = row0 + ai * HALF + m * 16; float rs = rs_of(sum16_fq(E.ss_in + (size_t)row * 16, fq), 1.f / 1024.f);
                if (u.pn < 2) rs *= 0.08838834764831845f;
#pragma unroll
                for (int bj = 0; bj < 2; ++bj) { const int col = col0 + bj * HALF; const f32x4 v0 = acc[ai][bj][m][0] * rs, v1 = acc[ai][bj][m][1] * rs;
                    if (col < 3072) { u32x4 w; w.x = pk2(v0[0], v0[1]); w.y = pk2(v0[2], v0[3]); w.z = pk2(v1[0], v1[1]); w.w = pk2(v1[2], v1[3]);
                        *(u32x4*)(E.o0 + (size_t)row * 3072 + col) = w; }
                    else if (col < 3088) { float* tp = E.f0 + (size_t)row * 16 + (col - 3072); *(f32x4*)tp = v0; *(f32x4*)(tp + 4) = v1; } } }
    } else {
#pragma unroll
        for (int ai = 0; ai < 2; ++ai)
#pragma unroll
            for (int m = 0; m < 4; ++m) { const int row = row0 + ai * HALF + m * 16; const float rs = rs_of(sum16_fq(E.ss_in + (size_t)row * 16, fq), 1.f / 1024.f);
#pragma unroll
                for (int bj = 0; bj < 2; ++bj) { const int col = col0 + bj * HALF; const f32x4 v0 = acc[ai][bj][m][0] * rs, v1 = acc[ai][bj][m][1] * rs;
                    if (col < 5120) { u32x4 w; w.x = pk2(v0[0], v0[1]); w.y = pk2(v0[2], v0[3]); w.z = pk2(v1[0], v1[1]); w.w = pk2(v1[2], v1[3]);
                        if (col < 2048) *(u32x4*)(E.o0 + (size_t)row * 2048 + col) = w; else *(u32x4*)(E.o1 + (size_t)row * 3072 + (col - 2048)) = w; }
                    else if (col < 5152) { float* tp = E.f0 + (size_t)row * 32 + (col - 5120); *(f32x4*)tp = v0; *(f32x4*)(tp + 4) = v1; } } }
    }
}

DI EpiD make_epi(int kind, int l, bool mini) {
    const Params& P = fresh_params(); unsigned char* ws = P.ws;
    float* ST = (float*)(ws + O_ST);
    EpiD e; e.mode = EM_RESID; e.alpha = 1.f; e.x = (float*)(ws + O_X); e.xin = e.x; e.xb = (bf16_t*)(ws + O_XB); e.ss_in = nullptr; e.ss_out = nullptr; e.o0 = nullptr; e.o1 = nullptr; e.f0 = nullptr; e.cs = nullptr; e.ppb = nullptr;
    switch (kind) {
    case K_A: case K_D: e.mode = EM_SWIGLU; e.ss_in = ST; e.o0 = (bf16_t*)(ws + O_R + R_ACT); break;
    case K_B: case K_E: e.alpha = 0.5f; e.ss_out = ST + (size_t)16 * T;
        if (kind == K_B && l == 0) e.xin = mini ? P.in[I_XS] - (size_t)TP * DM : P.in[I_XP];
        break;
    case K_PP: e.mode = EM_PLAIN; e.o0 = (bf16_t*)(ws + O_PP); break;
    case K_F: e.mode = EM_PLE; e.xb = (bf16_t*)(ws + O_XB2); e.ss_in = ST + (size_t)16 * T; e.ss_out = ST; e.ppb = (const bf16_t*)(ws + O_PP); break;
    case K_GM1: e.mode = EM_GMIN; e.ss_in = ST + (size_t)16 * T; e.o0 = (bf16_t*)(ws + O_R + R_U); e.o1 = (bf16_t*)(ws + O_R + R_V); e.f0 = ST + ST_GSP; break;
    case K_GM3: e.ss_out = ST; break;
    case K_PL2: e.cs = P.in[I_POOLSC]; e.ss_out = ST; break;
    case K_GL1: e.mode = EM_GLAIN; e.ss_in = ST + (size_t)16 * T; e.o0 = (bf16_t*)(ws + O_R + R_QKVR); e.f0 = (float*)(ws + O_R + R_T16); break;
    case K_GL5: e.ss_out = ST; break;
    case K_SS1: e.mode = EM_SSMIN; e.ss_in = ST + (size_t)16 * T; e.o0 = (bf16_t*)(ws + O_R + R_Z); e.o1 = (bf16_t*)(ws + O_R + R_XBC); e.f0 = (float*)(ws + O_R + R_DTR); break;
    default: e.ss_out = ST; break;
    }
    return e;
}

DI void gemm_phase(LAS unsigned char* lds, const GemmD g, const int kind, const int l) {
    const int tid = tid_(), wid = __builtin_amdgcn_readfirstlane(tid >> 6), lane = tid & 63, wr = wid >> 2, wc = wid & 3, fr = lane & 15, fq = lane >> 4;
    const int K = g.K, nt = K / BK; const int G = gdim_(), c = bid_();
    unsigned voffA[2], voffB[2];
#pragma unroll
    for (int i = 0; i < 2; ++i) { int R, C; stage_rc(tid * 16 + i * 8192, R, C); const int Rb = (R & ~31) + perm32(R & 31);
        voffA[i] = (unsigned)(R * g.lda + C) * 2u; voffB[i] = (unsigned)(Rb * g.ldb + C) * 2u; }
    const size_t kstep = (size_t)(BK * 2);
    const size_t hstepA = (size_t)HALF * g.lda * 2, hstepB = (size_t)HALF * g.ldb * 2;
    const size_t tstepA = 2 * hstepA, tstepB = 2 * hstepB, pnA = (size_t)g.a_pn_off * 2;
    const unsigned ldsw = (unsigned)wid * 1024u;
    const int aoff = lds_byte(wr * 64 + fr, fq * 8), boff = lds_byte(wc * 32 + fr, fq * 8);
#define PG8_SA(b, h) (((b) * 2 + (h)) * HTB)
#define PG8_SB(b, h) ((4 + (b) * 2 + (h)) * HTB)
#define PG8_STAGE(bufoff, gbase, voff) do { _Pragma("unroll") for (int _i = 0; _i < 2; ++_i) \
        __builtin_amdgcn_global_load_lds((const unsigned*)((const char*)(gbase) + (voff)[_i]), (LAS unsigned*)(lds + (bufoff) + ldsw + _i * 8192), 16, 0, 0); } while (0)
#define PG8_LDA(dst, b, h) do { _Pragma("unroll") for (int m = 0; m < 4; ++m) _Pragma("unroll") for (int k = 0; k < 2; ++k) dst[m][k] = *(const LAS bf16x8*)(lds + PG8_SA(b, h) + aoff + m * 2048 + k * 1024); } while (0)
#define PG8_LDB(dst, b, h) do { _Pragma("unroll") for (int n = 0; n < 2; ++n) _Pragma("unroll") for (int k = 0; k < 2; ++k) dst[n][k] = *(const LAS bf16x8*)(lds + PG8_SB(b, h) + boff + n * 2048 + k * 1024); } while (0)
#define PG8_MMA(ai, bj, At, Bt) do { __builtin_amdgcn_s_setprio(1); _Pragma("unroll") for (int m = 0; m < 4; ++m) _Pragma("unroll") for (int n = 0; n < 2; ++n) _Pragma("unroll") for (int k = 0; k < 2; ++k) \
        acc[ai][bj][m][n] = __builtin_amdgcn_mfma_f32_16x16x32_bf16(Bt[n][k], At[m][k], acc[ai][bj][m][n], 0, 0, 0); __builtin_amdgcn_s_setprio(0); } while (0)
#define PG8_WAIT_V(n) asm volatile("s_waitcnt vmcnt(" #n ")" ::: "memory")
#define PG8_WAIT_L(n) asm volatile("s_waitcnt lgkmcnt(" #n ")" ::: "memory")
#define PG8_BAR __builtin_amdgcn_s_barrier()
#define PG8_SCHED __builtin_amdgcn_sched_barrier(0)
    Unit cur, nxt; int ui = 0;
    if (!unit_at(g, 0, G, c, cur)) return;
    f32x4 acc[2][2][4][2];
#pragma unroll
    for (int a = 0; a < 2; ++a)
#pragma unroll
        for (int b = 0; b < 2; ++b)
#pragma unroll
            for (int m = 0; m < 4; ++m)
#pragma unroll
                for (int n = 0; n < 2; ++n) acc[a][b][m][n] = (f32x4){0.f, 0.f, 0.f, 0.f};
    bf16x8 At[4][2], B0[2][2], B1[2][2];
    const char* cA = (const char*)g.A + (size_t)cur.pm * tstepA + (size_t)cur.pn * pnA; const char* cB = (const char*)g.Bt + (size_t)cur.pn * tstepB;
    PG8_STAGE(PG8_SB(0, 0), cB, voffB); PG8_STAGE(PG8_SB(0, 1), cB + hstepB, voffB); PG8_STAGE(PG8_SA(0, 0), cA, voffA); PG8_STAGE(PG8_SA(0, 1), cA + hstepA, voffA);
    if (wr == 1) PG8_BAR;
    PG8_WAIT_V(2); PG8_BAR;
    PG8_STAGE(PG8_SB(1, 0), cB + kstep, voffB); PG8_STAGE(PG8_SA(1, 0), cA + kstep, voffA); PG8_STAGE(PG8_SB(1, 1), cB + hstepB + kstep, voffB);
    PG8_WAIT_V(6); PG8_BAR;
    for (;;) {
        const bool has_next = unit_at(g, ui + 1, G, c, nxt);
        const char* nA = has_next ? (const char*)g.A + (size_t)nxt.pm * tstepA + (size_t)nxt.pn * pnA : cA; const char* nB = has_next ? (const char*)g.Bt + (size_t)nxt.pn * tstepB : cB;
        for (int t = 0; t < nt; t += 2) {
            const bool last = (t == nt - 2);
            const char* a1 = cA + (size_t)(t + 1) * kstep;
            const char* a2 = last ? nA : cA + (size_t)(t + 2) * kstep; const char* b2 = last ? nB : cB + (size_t)(t + 2) * kstep;
            const char* a3 = a2 + kstep; const char* b3 = b2 + kstep;
            PG8_LDB(B0, 0, 0); PG8_LDB(B1, 0, 1); PG8_SCHED; PG8_LDA(At, 0, 0); PG8_STAGE(PG8_SA(1, 1), a1 + hstepA, voffA);
            PG8_WAIT_V(8); PG8_WAIT_L(0); PG8_BAR; PG8_MMA(0, 0, At, B0); PG8_MMA(0, 1, At, B1); PG8_BAR; PG8_SCHED;
            PG8_LDA(At, 0, 1); PG8_STAGE(PG8_SB(0, 0), b2, voffB); PG8_STAGE(PG8_SB(0, 1), b2 + hstepB, voffB); PG8_STAGE(PG8_SA(0, 0), a2, voffA);
            PG8_WAIT_V(8); PG8_WAIT_L(0); PG8_BAR; PG8_MMA(1, 0, At, B0); PG8_MMA(1, 1, At, B1); PG8_BAR; PG8_SCHED;
            PG8_LDB(B0, 1, 0); PG8_LDB(B1, 1, 1); PG8_SCHED; PG8_LDA(At, 1, 0); PG8_STAGE(PG8_SA(0, 1), a2 + hstepA, voffA);
            PG8_WAIT_V(8); PG8_WAIT_L(0); PG8_BAR; PG8_MMA(0, 0, At, B0); PG8_MMA(0, 1, At, B1); PG8_BAR; PG8_SCHED;
            PG8_LDA(At, 1, 1); PG8_STAGE(PG8_SB(1, 0), b3, voffB); PG8_STAGE(PG8_SB(1, 1), b3 + hstepB, voffB); PG8_STAGE(PG8_SA(1, 0), a3, voffA);
            PG8_WAIT_V(8); PG8_WAIT_L(0); PG8_BAR; PG8_MMA(1, 0, At, B0); PG8_MMA(1, 1, At, B1); PG8_BAR; PG8_SCHED;
        }
        if (wr == 0) PG8_BAR;
        epilogue(kind, l, acc, cur, wr, wc, fr, fq);
        __builtin_amdgcn_s_waitcnt(0x0F70);
        if (!has_next) break;
#pragma unroll
        for (int a = 0; a < 2; ++a)
#pragma unroll
            for (int b = 0; b < 2; ++b)
#pragma unroll
                for (int m = 0; m < 4; ++m)
#pragma unroll
                    for (int n = 0; n < 2; ++n) acc[a][b][m][n] = (f32x4){0.f, 0.f, 0.f, 0.f};
        cur = nxt; cA = nA; cB = nB; ++ui;
        if (wr == 1) PG8_BAR;
    }
    PG8_WAIT_V(0);
    PG8_BAR;
#undef PG8_SA
#undef PG8_SB
#undef PG8_STAGE
#undef PG8_LDA
#undef PG8_LDB
#undef PG8_MMA
#undef PG8_WAIT_V
#undef PG8_WAIT_L
#undef PG8_BAR
#undef PG8_SCHED
}

DI void mini_gemm(LAS unsigned char* lds, const GemmD g, const int kind, const int l) {
    const int tid = tid_(), wid = __builtin_amdgcn_readfirstlane(tid >> 6), lane = tid & 63, fr = lane & 15, fq = lane >> 4;
    LAS float* part = (LAS float*)lds;
    const int kw = g.K >> 3;
    for (int mu = bid_(); mu < 256; mu += gdim_()) {
        const int m0 = TP + (mu >> 4) * 32, n0 = (mu & 15) * 64;
        const bf16_t* Ab = g.A + (size_t)m0 * g.lda + (size_t)(n0 >> 8) * g.a_pn_off + wid * kw + 8 * fq;
        const bf16_t* Bb = g.Bt + (size_t)n0 * g.ldb + wid * kw + 8 * fq;
        f32x4 acc[2][4];
#pragma unroll
        for (int mb = 0; mb < 2; ++mb)
#pragma unroll
            for (int nb = 0; nb < 4; ++nb) acc[mb][nb] = (f32x4){0.f, 0.f, 0.f, 0.f};
#pragma unroll 4
        for (int k = 0; k < kw; k += 32) { bf16x8 a[2], b[4];
#pragma unroll
            for (int mb = 0; mb < 2; ++mb) a[mb] = *(const bf16x8*)(Ab + (size_t)(16 * mb + fr) * g.lda + k);
#pragma unroll
            for (int nb = 0; nb < 4; ++nb) b[nb] = *(const bf16x8*)(Bb + (size_t)(16 * nb + fr) * g.ldb + k);
#pragma unroll
            for (int mb = 0; mb < 2; ++mb)
#pragma unroll
                for (int nb = 0; nb < 4; ++nb) acc[mb][nb] = MFMA16(b[nb], a[mb], acc[mb][nb]); }
#pragma unroll
        for (int mb = 0; mb < 2; ++mb)
#pragma unroll
            for (int nb = 0; nb < 4; ++nb) *(LAS f32x4*)(part + (wid * 32 + 16 * mb + fr) * 68 + 16 * nb + 4 * fq) = acc[mb][nb];
        LDS_BARRIER();
        { const int r = tid >> 4, c4 = (tid & 15) * 4; f32x4 v = {0.f, 0.f, 0.f, 0.f};
#pragma unroll
          for (int w = 0; w < 8; ++w) v += *(const LAS f32x4*)(part + (w * 32 + r) * 68 + c4);
          const EpiD E = make_epi(kind, l, true); const int row = m0 + r, col = n0 + c4;
          if (E.mode == EM_PLAIN) { u32x2 w; w.x = pk2(v[0], v[1]); w.y = pk2(v[2], v[3]); *(u32x2*)(E.o0 + (size_t)row * DM + col) = w; }
          else { float* xp = E.x + (size_t)row * DM + col; f32x4 x0 = *(const f32x4*)(E.xin + (size_t)row * DM + col);
              if (E.mode == EM_PLE) { const float rs = rs_of(sum16(E.ss_in + (size_t)row * 16), 1.f / 1024.f); const u32x2 pw = *(const u32x2*)(E.ppb + (size_t)row * DM + col);
                  x0[0] += sigmoidf_(v[0] * rs) * bflo(pw.x) * E.alpha; x0[1] += sigmoidf_(v[1] * rs) * bfhi(pw.x) * E.alpha; x0[2] += sigmoidf_(v[2] * rs) * bflo(pw.y) * E.alpha; x0[3] += sigmoidf_(v[3] * rs) * bfhi(pw.y) * E.alpha; }
              else if (E.cs) x0 += v * *(const f32x4*)(E.cs + col) * E.alpha;
              else x0 += v * E.alpha;
              *(f32x4*)xp = x0; u32x2 w; w.x = pk2(x0[0], x0[1]); w.y = pk2(x0[2], x0[3]); *(u32x2*)(E.xb + (size_t)row * DM + col) = w;
              float sq = (x0[0] * x0[0] + x0[1] * x0[1]) + (x0[2] * x0[2] + x0[3] * x0[3]);
              sq += __shfl_xor(sq, 1); sq += __shfl_xor(sq, 2); sq += __shfl_xor(sq, 4); sq += __shfl_xor(sq, 8);
              if ((tid & 15) == 0) E.ss_out[(size_t)row * 16 + (n0 >> 6)] = sq; } }
        LDS_BARRIER();
    }
}

struct Job { const float* src; const float* scale; bf16_t* dst; int K, N, ldk, mode; };
constexpr int NJOBS = 42;
DI Job get_job(const Params& P, int j) {
    Job b; b.scale = nullptr; b.mode = 0;
    unsigned char* ws = P.ws;
    if (j < 32) { const int l = j >> 3, s = j & 7;
        if (s == 0 || s == 1 || s == 3 || s == 4) { const bool second = s >= 3; const bool up = (s == 1 || s == 4);
            b.src = P.in[second ? (up ? I_F2U : I_F2G) : (up ? I_F1U : I_F1G)] + (size_t)l * 1024 * FF; b.scale = P.in[second ? I_NF2 : I_NF1] + l * 1024;
            b.dst = (bf16_t*)(ws + (second ? O_W2 : O_W1) + (size_t)l * SZ_W1); b.K = 1024; b.N = FF; b.ldk = 1024; b.mode = up ? 2 : 1;
        } else if (s == 2 || s == 5) { const bool second = s == 5;
            b.src = P.in[second ? I_F2D : I_F1D] + (size_t)l * FF * 1024; b.dst = (bf16_t*)(ws + (second ? O_D2 : O_D1) + (size_t)l * SZ_D1); b.K = FF; b.N = 1024; b.ldk = FF;
        } else if (s == 6) { b.src = P.in[I_PLEG] + (size_t)l * 1024 * 1024; b.scale = P.in[I_NPLE] + l * 1024; b.dst = (bf16_t*)(ws + O_PG + (size_t)l * SZ_SQ); b.K = 1024; b.N = 1024; b.ldk = 1024;
        } else { b.src = P.in[I_PLEP] + (size_t)l * 256 * 1024; b.dst = (bf16_t*)(ws + O_PPW + (size_t)l * SZ_PPW); b.K = 256; b.N = 1024; b.ldk = 256; }
    } else if (j == 32) { b.src = P.in[I_GMIN]; b.scale = P.in[I_NMIX]; b.dst = (bf16_t*)(ws + O_GMIN); b.K = 1024; b.N = 2048; b.ldk = 1024;
    } else if (j == 33) { b.src = P.in[I_GMOUT]; b.dst = (bf16_t*)(ws + O_GMOUT); b.K = 1024; b.N = 1024; b.ldk = 1024;
    } else if (j < 38) { const int gi = j - 34; b.src = P.in[I_POOLW] + (size_t)gi * 65536; b.dst = (bf16_t*)(ws + O_POOLW) + (size_t)gi * 65536; b.K = 256; b.N = 256; b.ldk = 256;
    } else if (j == 38) { b.src = P.in[I_GLAIN]; b.scale = P.in[I_NMIX] + 2048; b.dst = (bf16_t*)(ws + O_GLAIN); b.K = 1024; b.N = 3072; b.ldk = 1024;
    } else if (j == 39) { b.src = P.in[I_GLAOUT]; b.dst = (bf16_t*)(ws + O_GLAOUT); b.K = 1024; b.N = 1024; b.ldk = 1024;
    } else if (j == 40) { b.src = P.in[I_SSMIN]; b.scale = P.in[I_NMIX] + 3072; b.dst = (bf16_t*)(ws + O_SSMIN); b.K = 1024; b.N = 5152; b.ldk = 1024;
    } else { b.src = P.in[I_SSMOUT]; b.scale = P.in[I_SSMNORM]; b.dst = (bf16_t*)(ws + O_SSMOUT); b.K = 2048; b.N = 1024; b.ldk = 2048; }
    return b;
}
DI void transpose_item(const Job& jb, int item, LAS float* scr, int lane) {
    const int nblk = (jb.N + 63) >> 6, kb = item / nblk, nb = item - kb * nblk, k0 = 32 * kb, n0 = 64 * nb;
    const int nl = (lane & 15) * 4, kr = lane >> 4;
    const bool ok = (n0 + nl) < jb.N;
    f32x4 v[8];
#pragma unroll
    for (int i = 0; i < 8; ++i) v[i] = ok ? __builtin_nontemporal_load((const f32x4*)(jb.src + (size_t)(k0 + 4 * i + kr) * jb.N + n0 + nl)) : (f32x4){0.f, 0.f, 0.f, 0.f};
#pragma unroll
    for (int i = 0; i < 8; ++i) { const int kk = 4 * i + kr; const float sc = jb.scale ? jb.scale[k0 + kk] : 1.f; LAS float* d = scr + kk * 65 + nl;
        d[0] = v[i][0] * sc; d[1] = v[i][1] * sc; d[2] = v[i][2] * sc; d[3] = v[i][3] * sc; }
    asm volatile("s_waitcnt lgkmcnt(0)" ::: "memory");
    const int c = lane & 3;
#pragma unroll
    for (int j = 0; j < 4; ++j) { const int n = (lane >> 2) + 16 * j; const LAS float* s = scr + (8 * c) * 65 + n;
        u32x4 o; o.x = pk2(s[0 * 65], s[1 * 65]); o.y = pk2(s[2 * 65], s[3 * 65]); o.z = pk2(s[4 * 65], s[5 * 65]); o.w = pk2(s[6 * 65], s[7 * 65]);
        const int nn = n0 + n;
        if (nn < jb.N) { const int drow = jb.mode == 0 ? nn : ((nn >> 2) * 8 + (nn & 3) + (jb.mode == 2 ? 4 : 0)); *(u32x4*)(jb.dst + (size_t)drow * jb.ldk + k0 + 8 * c) = o; } }
    asm volatile("s_waitcnt lgkmcnt(0)" ::: "memory");
}

DI void phase0(const Params& P, LAS unsigned char* lds) {
    const int tid = tid_(), wid = tid >> 6, lane = tid & 63;
    const int gw = bid_() * 8 + wid, NW = gdim_() * 8;
    const int gt = bid_() * 512 + tid, NT = gdim_() * 512;
    unsigned char* ws = P.ws;
    { float* X = (float*)(ws + O_X); bf16_t* XB = (bf16_t*)(ws + O_XB); float* ST = (float*)(ws + O_ST);
      for (int row = gw; row < T; row += NW) {
          const float* src = row < TP ? P.in[I_XP] + (size_t)row * DM : P.in[I_XS] + (size_t)(row - TP) * DM;
          float sq = 0.f;
#pragma unroll
          for (int j = 0; j < 4; ++j) { const f32x4 v = *(const f32x4*)(src + lane * 4 + 256 * j);
              u32x2 w; w.x = pk2(v[0], v[1]); w.y = pk2(v[2], v[3]); *(u32x2*)(XB + (size_t)row * DM + lane * 4 + 256 * j) = w;
              sq += (v[0] * v[0] + v[1] * v[1]) + (v[2] * v[2] + v[3] * v[3]); }
#pragma unroll
          for (int o = 32; o >= 1; o >>= 1) sq += __shfl_xor(sq, o);
          if (lane < 16) ST[(size_t)row * 16 + lane] = lane == 0 ? sq : 0.f; } }
    { bf16_t* GI = (bf16_t*)(ws + O_GLAIN); const float* a1 = P.in[I_GLAA1]; const float* g = P.in[I_NMIX] + 2048;
      for (int i = gt; i < 16 * 1024; i += NT) { const int n = i >> 10, k = i & 1023; GI[(size_t)(3072 + n) * 1024 + k] = f2bf(a1[k * 16 + n] * g[k]); }
      bf16_t* WS = (bf16_t*)(ws + O_WSB); const float* w = P.in[I_GMWS];
      for (int i = gt; i < 8 * 128 * 128; i += NT) { const int t = (i >> 7) & 127, s = i & 127; WS[i] = f2bf(s <= t ? w[i] : 0.f); } }
    { LAS float* scr = (LAS float*)lds + wid * (32 * 65);
      int start = gw;
      for (int j = 0; j < NJOBS; ++j) { const Job jb = get_job(P, j); const int n = (jb.K / 32) * ((jb.N + 63) >> 6);
          for (int it = start; it < n; it += NW) transpose_item(jb, it, scr, lane);
          start = (((start - n) % NW) + NW) % NW; } }
}

DI void conv_p(const Params& P, int l) {
    const int gt = bid_() * 512 + tid_(), NT = gdim_() * 512; bf16_t* PB = (bf16_t*)(P.ws + O_PBF);
#pragma unroll 4
    for (int i = gt; i < T * 64; i += NT) { const int row = i >> 6, c4 = (i & 63) * 4;
        const float* src = row < TP ? P.in[I_PP] + ((size_t)l * TP + row) * 256 + c4 : P.in[I_PS] + ((size_t)l * 512 + (row - TP)) * 256 + c4;
        const f32x4 v = *(const f32x4*)src; u32x2 w; w.x = pk2(v[0], v[1]); w.y = pk2(v[2], v[3]); *(u32x2*)(PB + (size_t)row * 256 + c4) = w; }
}

DI void gm_spatial(const Params& P, LAS unsigned char* lds) {
    const int tid = tid_(), wid = __builtin_amdgcn_readfirstlane(tid >> 6), lane = tid & 63, fr = lane & 15, fq = lane >> 4;
    unsigned char* ws = P.ws;
    const bf16_t* U = (const bf16_t*)(ws + O_R + R_U); const bf16_t* V = (const bf16_t*)(ws + O_R + R_V); bf16_t* GU = (bf16_t*)(ws + O_R + R_GU);
    const float* GS = (const float*)(ws + O_ST) + ST_GSP; const bf16_t* WSB = (const bf16_t*)(ws + O_WSB);
    const float* lng = P.in[I_GMLN]; const float* bs = P.in[I_GMBS];
    LAS bf16_t* Vt = (LAS bf16_t*)lds;
    for (int u = bid_(); u < 1024; u += gdim_()) {
        const int g = u & 7, row0 = (u >> 3) * 128;
        { const int s = tid & 127; const int row = row0 + s; float s1 = 0.f, s2 = 0.f;
#pragma unroll
          for (int q = 0; q < 8; ++q) { const f32x4 gq = *(const f32x4*)(GS + (size_t)row * 32 + 4 * q); s1 += gq[0] + gq[2]; s2 += gq[1] + gq[3]; }
          const float mean = s1 * (1.f / 1024.f); const float var = s2 * (1.f / 1024.f) - mean * mean; const float rstd = rsqrtf(var + EPS);
#pragma unroll
          for (int i = 0; i < 4; ++i) { const int c8 = ((tid >> 7) + 4 * i) * 8; const u32x4 w = *(const u32x4*)(V + (size_t)row * DM + g * 128 + c8); float f[8]; unpack8(w, f);
#pragma unroll
              for (int j = 0; j < 8; ++j) Vt[(c8 + j) * 136 + s] = f2bf((f[j] - mean) * rstd * lng[g * 128 + c8 + j]); } }
        LDS_BARRIER();
        f32x4 acc[8];
#pragma unroll
        for (int nb = 0; nb < 8; ++nb) acc[nb] = (f32x4){0.f, 0.f, 0.f, 0.f};
        const int nks = (wid >> 1) + 1;
        for (int ks = 0; ks < nks; ++ks) {
            const bf16x8 a = *(const bf16x8*)(WSB + (size_t)(g * 128 + 16 * wid + fr) * 128 + 32 * ks + 8 * fq);
#pragma unroll
            for (int nb = 0; nb < 8; ++nb) { const bf16x8 b = *(const LAS bf16x8*)(Vt + (16 * nb + fr) * 136 + 32 * ks + 8 * fq); acc[nb] = MFMA16(b, a, acc[nb]); } }
        { const int tl = 16 * wid + fr; const float bias = bs[g * 128 + tl]; const size_t rb = (size_t)(row0 + tl) * DM + g * 128 + 4 * fq;
#pragma unroll
          for (int nb = 0; nb < 8; ++nb) { const u32x2 uw = *(const u32x2*)(U + rb + 16 * nb); u32x2 w;
              w.x = pk2(bflo(uw.x) * (acc[nb][0] + bias), bfhi(uw.x) * (acc[nb][1] + bias)); w.y = pk2(bflo(uw.y) * (acc[nb][2] + bias), bfhi(uw.y) * (acc[nb][3] + bias));
              *(u32x2*)(GU + rb + 16 * nb) = w; } }
        LDS_BARRIER();
    }
    { const int gt = bid_() * 512 + tid, NT = gdim_() * 512; const float* wsf = P.in[I_GMWS]; float* CV = P.out + OUT_CV;
      for (int e = gt; e < 128 * 1024; e += NT) { const int b = e >> 10, c = e & 1023, g = c >> 7; float vl[4];
#pragma unroll
          for (int s = 0; s < 4; ++s) { const int row = TP + 4 * b + s; float s1 = 0.f, s2 = 0.f;
#pragma unroll
              for (int q = 0; q < 8; ++q) { const f32x4 gq = *(const f32x4*)(GS + (size_t)row * 32 + 4 * q); s1 += gq[0] + gq[2]; s2 += gq[1] + gq[3]; }
              const float mean = s1 * (1.f / 1024.f); const float var = s2 * (1.f / 1024.f) - mean * mean;
              vl[s] = (bf2f(V[(size_t)row * DM + c]) - mean) * rsqrtf(var + EPS) * lng[c]; CV[(size_t)(4 * b + s) * DM + c] = vl[s]; }
#pragma unroll
          for (int t = 0; t < 4; ++t) { float sv = bs[g * 128 + t];
#pragma unroll
              for (int s = 0; s <= t; ++s) sv += wsf[(g * 128 + t) * 128 + s] * vl[s];
              const size_t o = (size_t)(TP + 4 * b + t) * DM + c; GU[o] = f2bf(bf2f(U[o]) * sv); } } }
}

DI void pool_prep(const Params& P, LAS unsigned char* lds) {
    const int tid = tid_(); unsigned char* ws = P.ws;
    const float* X = (const float*)(ws + O_X); const float* SS = (const float*)(ws + O_ST) + (size_t)16 * T; bf16_t* DF = (bf16_t*)(ws + O_R + R_DIFF);
    const float* gm = P.in[I_NMIX] + 1024; const float* hist = P.in[I_SPOOL];
    const int sub = tid >> 8, c4 = (tid & 255) * 4, w = 2 << (c4 >> 8);
    const f32x4 g4 = *(const f32x4*)(gm + c4);
    LAS float* rsl = (LAS float*)lds + sub * 32;
    for (int it = bid_() * 2 + sub; it < 1152; it += gdim_() * 2) {
        LDS_BARRIER();
        if (it < 1024) { const int b = it >> 7, t0 = (it & 127) * 16; const size_t rb = (size_t)b * 2048; const int k = tid & 255;
            if (k < 31) { const int tt = t0 - 15 + k; rsl[k] = tt >= 0 ? rs_of(sum16(SS + (rb + tt) * 16), 1.f / 1024.f) : 0.f; } }
        LDS_BARRIER();
        if (it < 1024) { const int b = it >> 7, t0 = (it & 127) * 16; const size_t rb = (size_t)b * 2048;
            f32x4 sum = {0.f, 0.f, 0.f, 0.f};
            for (int j = 1; j < w; ++j) { const int tt = t0 - j; if (tt >= 0) { const float rs = rsl[15 - j]; sum += *(const f32x4*)(X + (rb + tt) * DM + c4) * g4 * rs; } }
#pragma unroll 8
            for (int t = t0; t < t0 + 16; ++t) { const float rs = rsl[t - t0 + 15]; const f32x4 cur = *(const f32x4*)(X + (rb + t) * DM + c4) * g4 * rs;
                sum += cur; const float ic = __builtin_amdgcn_rcpf((float)(t + 1 < w ? t + 1 : w)); const f32x4 d = sum * ic - cur;
                u32x2 o; o.x = pk2(d[0], d[1]); o.y = pk2(d[2], d[3]); *(u32x2*)(DF + (rb + t) * DM + c4) = o;
                if (t >= 2033) *(f32x4*)(P.out + OUT_POOLP + ((size_t)b * 15 + (t - 2033)) * DM + c4) = cur;
                const int tt = t - w + 1; if (tt >= 0) { const float r2 = rsl[tt - t0 + 15]; sum -= *(const f32x4*)(X + (rb + tt) * DM + c4) * g4 * r2; } }
        } else { const int b = it - 1024; const size_t rb = (size_t)TP + 4 * b; const float* hb = hist + (size_t)b * 15 * DM + c4;
            f32x4 sum = {0.f, 0.f, 0.f, 0.f}; f32x4 hc[4];
            for (int j = 1; j < w; ++j) sum += *(const f32x4*)(hb + (size_t)(15 - j) * DM);
            const float ic = 1.f / (float)w;
#pragma unroll
            for (int t = 0; t < 4; ++t) { const float rs = rs_of(sum16(SS + (rb + t) * 16), 1.f / 1024.f); const f32x4 cur = *(const f32x4*)(X + (rb + t) * DM + c4) * g4 * rs; hc[t] = cur;
                sum += cur; const f32x4 d = sum * ic - cur; u32x2 o; o.x = pk2(d[0], d[1]); o.y = pk2(d[2], d[3]); *(u32x2*)(DF + (rb + t) * DM + c4) = o;
                const int tt = t - w + 1; f32x4 old;
                if (tt >= 0) old = (tt == 0 ? hc[0] : (tt == 1 ? hc[1] : hc[2])); else old = *(const f32x4*)(hb + (size_t)(15 + tt) * DM);
                sum -= old; }
            float* po = P.out + OUT_POOLS + (size_t)b * 15 * DM + c4;
            for (int j = 0; j < 11; ++j) *(f32x4*)(po + (size_t)j * DM) = *(const f32x4*)(hb + (size_t)(4 + j) * DM);
#pragma unroll
            for (int j = 0; j < 4; ++j) *(f32x4*)(po + (size_t)(11 + j) * DM) = hc[j];
        }
    }
}

DI void gla_prep(const Params& P, LAS unsigned char* lds) {
    const int ch = tid_(); unsigned char* ws = P.ws;
    const bf16_t* QK = (const bf16_t*)(ws + O_R + R_QKVR); const float* T16 = (const float*)(ws + O_R + R_T16);
    bf16_t* QD = (bf16_t*)(ws + O_R + R_QD); bf16_t* KI = (bf16_t*)(ws + O_R + R_KI); float* DEC = (float*)(ws + O_R + R_DEC); float* SA = (float*)(ws + O_R + R_SA);
    float w2[16];
#pragma unroll
    for (int r = 0; r < 16; ++r) w2[r] = P.in[I_GLAA2][r * 512 + ch];
    const float ba = P.in[I_GLABA][ch];
    for (int it = bid_(); it < 384; it += gdim_()) {
        const bool prompt = it < 256; const int row0 = prompt ? it * 64 : TP + (it - 256) * 4; const int nt = prompt ? 64 : 4;
        float b = 0.f;
        LAS float* t16s = (LAS float*)lds;
        LDS_BARRIER();
        for (int i = ch; i < nt * 4; i += 512) *(LAS f32x4*)(t16s + 4 * i) = *(const f32x4*)(T16 + (size_t)row0 * 16 + 4 * i);
        LDS_BARRIER();
#pragma unroll 4
        for (int t = 0; t < nt; ++t) { const int row = row0 + t; float z = ba;
#pragma unroll
            for (int r4 = 0; r4 < 4; ++r4) { const f32x4 tv = *(const LAS f32x4*)(t16s + t * 16 + 4 * r4); z += tv[0] * w2[4 * r4] + tv[1] * w2[4 * r4 + 1] + tv[2] * w2[4 * r4 + 2] + tv[3] * w2[4 * r4 + 3]; }
            const float la = (fminf(z, 0.f) - __logf(1.0f + __expf(-fabsf(z)))) * (1.f / 16.f);
            if (prompt) { b += la; const float q = bf2f(QK[(size_t)row * 3072 + ch]), k = bf2f(QK[(size_t)row * 3072 + 512 + ch]);
                QD[(size_t)row * 512 + ch] = f2bf(q * __expf(b)); KI[(size_t)row * 512 + ch] = f2bf(k * __expf(-b)); }
            else SA[(size_t)(row - TP) * 512 + ch] = __expf(la); }
        if (prompt) DEC[(size_t)it * 512 + ch] = __expf(b);
    }
}

DI void gla_scan(const Params& P, LAS unsigned char* lds) {
    const int tid = tid_(), wid = __builtin_amdgcn_readfirstlane(tid >> 6), lane = tid & 63, fr = lane & 15, fq = lane >> 4;
    unsigned char* ws = P.ws;
    const bf16_t* QK = (const bf16_t*)(ws + O_R + R_QKVR); const bf16_t* QD = (const bf16_t*)(ws + O_R + R_QD); const bf16_t* KI = (const bf16_t*)(ws + O_R + R_KI);
    const float* DEC = (const float*)(ws + O_R + R_DEC); const float* SA = (const float*)(ws + O_R + R_SA); bf16_t* OB = (bf16_t*)(ws + O_R + R_OBUF);
    float* GSS = (float*)(ws + O_ST) + ST_GSSP;
    constexpr int GSET = 9216 + 4608 + 8704 + 18432;
    LAS bf16_t* St0 = (LAS bf16_t*)(lds + 9216 + 4608);
    const int mb = wid >> 1, vb = wid & 1;
    for (int it = bid_(); it < 256; it += gdim_()) {
        const int vs = it & 7, h = (it >> 3) & 3, b = it >> 5;
        f32x4 Sacc[2] = {{0.f, 0.f, 0.f, 0.f}, {0.f, 0.f, 0.f, 0.f}};
        for (int i = tid; i < 32 * 136 / 2; i += 512) ((LAS unsigned*)St0)[i] = 0u;
        u32x4 vw = {0u, 0u, 0u, 0u}, kw[2]; bf16x8 qa[4], kbf[2][4]; f32x4 dc;
#define GLA_LOAD(ROW0, NCH, QA, DC) do { \
            if (tid < 256) vw = *(const u32x4*)(QK + (size_t)((ROW0) + (tid & 63)) * 3072 + 1024 + h * 256 + vs * 32 + (tid >> 6) * 8); \
            _Pragma("unroll") for (int i_ = 0; i_ < 2; ++i_) { const int idx_ = tid + 512 * i_; kw[i_] = *(const u32x4*)(KI + (size_t)((ROW0) + (idx_ & 63)) * 512 + h * 128 + (idx_ >> 6) * 8); } \
            _Pragma("unroll") for (int ks_ = 0; ks_ < 4; ++ks_) QA[ks_] = *(const bf16x8*)(QD + (size_t)((ROW0) + 16 * mb + fr) * 512 + h * 128 + 32 * ks_ + 8 * fq); \
            _Pragma("unroll") for (int i_ = 0; i_ < 2; ++i_) _Pragma("unroll") for (int ks_ = 0; ks_ < 4; ++ks_) kbf[i_][ks_] = *(const bf16x8*)(KI + (size_t)((ROW0) + 16 * (2 * vb + i_) + fr) * 512 + h * 128 + 32 * ks_ + 8 * fq); \
            DC = *(const f32x4*)(DEC + (size_t)(NCH) * 512 + h * 128 + 16 * wid + 4 * fq); } while (0)
        GLA_LOAD(b * 2048, b * 32, qa, dc);
        for (int n = 0; n < 32; ++n) {
            const int row0 = b * 2048 + 64 * n;
            LAS unsigned char* sb_ = lds + (n & 1) * GSET; LAS unsigned char* so_ = lds + ((n & 1) ^ 1) * GSET;
            LAS bf16_t* Pm = (LAS bf16_t*)sb_; LAS bf16_t* Vt = (LAS bf16_t*)(sb_ + 9216); LAS bf16_t* St = (LAS bf16_t*)(sb_ + 13824); LAS bf16_t* KIt = (LAS bf16_t*)(sb_ + 22528);
            LAS bf16_t* Stn = (LAS bf16_t*)(so_ + 13824);
            if (tid < 256) { const int s = tid & 63, v8 = (tid >> 6) * 8; const bf16_t* e = (const bf16_t*)&vw;
#pragma unroll
                for (int j = 0; j < 8; ++j) Vt[(v8 + j) * 72 + s] = e[j]; }
#pragma unroll
            for (int i = 0; i < 2; ++i) { const int idx = tid + 512 * i, s = idx & 63, d8 = (idx >> 6) * 8; const bf16_t* e = (const bf16_t*)&kw[i];
#pragma unroll
                for (int j = 0; j < 8; ++j) KIt[(d8 + j) * 72 + s] = e[j]; }
#pragma unroll
            for (int i = 0; i < 2; ++i) { const int nb = 2 * vb + i; f32x4 sc = {0.f, 0.f, 0.f, 0.f};
#pragma unroll
                for (int ks = 0; ks < 4; ++ks) sc = MFMA16(qa[ks], kbf[i][ks], sc);
#pragma unroll
                for (int j = 0; j < 4; ++j) { const int t = 16 * mb + 4 * fq + j, s = 16 * nb + fr; Pm[t * 72 + s] = f2bf(s <= t ? sc[j] : 0.f); } }
            LDS_BARRIER();
            bf16x8 qn[4]; f32x4 dn = dc;
#pragma unroll
            for (int ks = 0; ks < 4; ++ks) qn[ks] = qa[ks];
            if (n + 1 < 32) GLA_LOAD(row0 + 64, b * 32 + n + 1, qn, dn);
            f32x4 o = {0.f, 0.f, 0.f, 0.f};
#pragma unroll
            for (int k2 = 0; k2 < 2; ++k2) { const bf16x8 a = *(const LAS bf16x8*)(Pm + (16 * mb + fr) * 72 + 32 * k2 + 8 * fq); const bf16x8 bb = *(const LAS bf16x8*)(Vt + (16 * vb + fr) * 72 + 32 * k2 + 8 * fq); o = MFMA16(a, bb, o); }
#pragma unroll
            for (int ks = 0; ks < 4; ++ks) { const bf16x8 bb = *(const LAS bf16x8*)(St + (16 * vb + fr) * 136 + 32 * ks + 8 * fq); o = MFMA16(qa[ks], bb, o); }
#pragma unroll
            for (int j = 0; j < 4; ++j) { const int row = row0 + 16 * mb + 4 * fq + j; OB[(size_t)row * DM + h * 256 + vs * 32 + 16 * vb + fr] = f2bf(o[j]); }
#pragma unroll
            for (int k2 = 0; k2 < 2; ++k2) { const bf16x8 a = *(const LAS bf16x8*)(KIt + (16 * wid + fr) * 72 + 32 * k2 + 8 * fq);
#pragma unroll
                for (int v2 = 0; v2 < 2; ++v2) { const bf16x8 bb = *(const LAS bf16x8*)(Vt + (16 * v2 + fr) * 72 + 32 * k2 + 8 * fq); Sacc[v2] = MFMA16(a, bb, Sacc[v2]); } }
            Sacc[0] *= dc; Sacc[1] *= dc;
#pragma unroll
            for (int v2 = 0; v2 < 2; ++v2) { u32x2 w; w.x = pk2(Sacc[v2][0], Sacc[v2][1]); w.y = pk2(Sacc[v2][2], Sacc[v2][3]); *(LAS u32x2*)(Stn + (16 * v2 + fr) * 136 + 16 * wid + 4 * fq) = w; }
#pragma unroll
            for (int ks = 0; ks < 4; ++ks) qa[ks] = qn[ks];
            dc = dn;
        }
#undef GLA_LOAD
        float* GO = P.out + OUT_GLAP + ((size_t)(b * 4 + h) * 128) * 256 + vs * 32;
#pragma unroll
        for (int v2 = 0; v2 < 2; ++v2)
#pragma unroll
            for (int j = 0; j < 4; ++j) GO[(size_t)(16 * wid + 4 * fq + j) * 256 + 16 * v2 + fr] = Sacc[v2][j];
        LDS_BARRIER();
    }
    LAS float* red = (LAS float*)lds;
    for (int it = bid_(); it < 512; it += gdim_()) {
        const int b = it >> 2, h = it & 3; const int v4 = lane * 4;
        const float* S0 = P.in[I_SGLA] + ((size_t)(b * 4 + h) * 128 + 16 * wid) * 256 + v4;
        f32x4 S[16];
#pragma unroll
        for (int i = 0; i < 16; ++i) S[i] = *(const f32x4*)(S0 + (size_t)i * 256);
#pragma unroll
        for (int t = 0; t < 4; ++t) { const int row = TP + 4 * b + t; const bf16_t* qk = QK + (size_t)row * 3072;
            const u32x2 vw = *(const u32x2*)(qk + 1024 + h * 256 + v4); const f32x4 v = {bflo(vw.x), bfhi(vw.x), bflo(vw.y), bfhi(vw.y)};
            f32x4 po = {0.f, 0.f, 0.f, 0.f};
            const int dl = h * 128 + 16 * wid + (lane & 15);
            const float a_l = SA[(size_t)(4 * b + t) * 512 + dl]; const float q_l = bf2f(qk[dl]), k_l = bf2f(qk[512 + dl]);
#pragma unroll
            for (int i = 0; i < 16; ++i) { const float a = __builtin_bit_cast(float, __builtin_amdgcn_readlane(__builtin_bit_cast(int, a_l), i));
                const float q = __builtin_bit_cast(float, __builtin_amdgcn_readlane(__builtin_bit_cast(int, q_l), i)), k = __builtin_bit_cast(float, __builtin_amdgcn_readlane(__builtin_bit_cast(int, k_l), i));
                S[i] = S[i] * a + v * k; po += S[i] * q; }
            *(LAS f32x4*)(red + (t * 8 + wid) * 256 + v4) = po; }
        float* SO = P.out + OUT_GLAS + ((size_t)(b * 4 + h) * 128 + 16 * wid) * 256 + v4;
#pragma unroll
        for (int i = 0; i < 16; ++i) __builtin_nontemporal_store(S[i], (f32x4*)(SO + (size_t)i * 256));
        LDS_BARRIER();
#pragma unroll
        for (int i = 0; i < 2; ++i) { const int idx = tid + 512 * i, t = idx >> 8, v = idx & 255; float o = 0.f;
#pragma unroll
            for (int w = 0; w < 8; ++w) o += red[(t * 8 + w) * 256 + v];
            const int row = TP + 4 * b + t; OB[(size_t)row * DM + h * 256 + v] = f2bf(o); }
        LDS_BARRIER();
    }
}

DI void gla_gate(const Params& P) {
    unsigned char* ws = P.ws; const int tid = tid_(), lane = tid & 63; const int gw = bid_() * 8 + (tid >> 6), NW = gdim_() * 8;
    const bf16_t* QK = (const bf16_t*)(ws + O_R + R_QKVR); bf16_t* OB = (bf16_t*)(ws + O_R + R_OBUF); const float* gn = P.in[I_GLANORM];
    const int c16 = lane * 16;
    float g[16];
#pragma unroll
    for (int q = 0; q < 4; ++q) { const f32x4 gv = *(const f32x4*)(gn + c16 + 4 * q); g[4 * q] = gv[0]; g[4 * q + 1] = gv[1]; g[4 * q + 2] = gv[2]; g[4 * q + 3] = gv[3]; }
#pragma unroll 2
    for (int row = gw; row < T; row += NW) {
        float o[16], r[16];
        unpack8(*(const u32x4*)(OB + (size_t)row * DM + c16), o); unpack8(*(const u32x4*)(OB + (size_t)row * DM + c16 + 8), o + 8);
        unpack8(*(const u32x4*)(QK + (size_t)row * 3072 + 2048 + c16), r); unpack8(*(const u32x4*)(QK + (size_t)row * 3072 + 2048 + c16 + 8), r + 8);
        float sq = 0.f;
#pragma unroll
        for (int j = 0; j < 16; ++j) sq += o[j] * o[j];
        sq += __shfl_xor(sq, 1); sq += __shfl_xor(sq, 2); sq += __shfl_xor(sq, 4); sq += __shfl_xor(sq, 8);
        const float rs = rs_of(sq, 1.f / 256.f);
#pragma unroll
        for (int j = 0; j < 16; ++j) o[j] = o[j] * rs * g[j] * siluf_(r[j]);
        *(u32x4*)(OB + (size_t)row * DM + c16) = pack8(o); *(u32x4*)(OB + (size_t)row * DM + c16 + 8) = pack8(o + 8); }
}

DI void ssd_conv(const Params& P) {
    unsigned char* ws = P.ws; const int tid = tid_(); const int gt = bid_() * 512 + tid, NT = gdim_() * 512;
    const bf16_t* XBC = (const bf16_t*)(ws + O_R + R_XBC); bf16_t* XS = (bf16_t*)(ws + O_R + R_XBCS); const float* DTR = (const float*)(ws + O_R + R_DTR); float* DT = (float*)(ws + O_R + R_DT);
    const float* cw = P.in[I_SSMCW]; const float* cb = P.in[I_SSMCB]; const float* cs0 = P.in[I_SCONV];
    if (tid < 384) {
        const int c8 = tid * 8; float w[4][8], cbv[8];
#pragma unroll
        for (int jj = 0; jj < 4; ++jj) { const f32x4 a = *(const f32x4*)(cw + (size_t)jj * 3072 + c8), bq = *(const f32x4*)(cw + (size_t)jj * 3072 + c8 + 4);
#pragma unroll
            for (int j = 0; j < 4; ++j) { w[jj][j] = a[j]; w[jj][4 + j] = bq[j]; } }
        { const f32x4 a = *(const f32x4*)(cb + c8), bq = *(const f32x4*)(cb + c8 + 4);
#pragma unroll
          for (int j = 0; j < 4; ++j) { cbv[j] = a[j]; cbv[4 + j] = bq[j]; } }
        for (int it = bid_(); it < 640; it += gdim_()) {
            const bool prompt = it < 512; const int b = prompt ? (it >> 6) : (it - 512); const int t0 = prompt ? (it & 63) * 32 : 0; const int row0 = prompt ? it * 32 : TP + 4 * b; const int nrows = prompt ? 32 : 4;
            float h1[8], h2[8], h3[8];
            if (prompt) { if (t0 > 0) { unpack8(*(const u32x4*)(XBC + (size_t)(row0 - 1) * 3072 + c8), h1); unpack8(*(const u32x4*)(XBC + (size_t)(row0 - 2) * 3072 + c8), h2); unpack8(*(const u32x4*)(XBC + (size_t)(row0 - 3) * 3072 + c8), h3); }
                else {
#pragma unroll
                    for (int j = 0; j < 8; ++j) { h1[j] = 0.f; h2[j] = 0.f; h3[j] = 0.f; } } }
            else { const float* sp = cs0 + (size_t)b * 3 * 3072 + c8;
#pragma unroll
                for (int j = 0; j < 8; ++j) { h1[j] = sp[2 * 3072 + j]; h2[j] = sp[3072 + j]; h3[j] = sp[j]; } }
#pragma unroll 8
            for (int r = 0; r < nrows; ++r) { const int row = row0 + r, t = t0 + r; float cur[8], acc[8]; unpack8(*(const u32x4*)(XBC + (size_t)row * 3072 + c8), cur);
#pragma unroll
                for (int j = 0; j < 8; ++j) { acc[j] = siluf_(cbv[j] + w[3][j] * cur[j] + w[2][j] * h1[j] + w[1][j] * h2[j] + w[0][j] * h3[j]); h3[j] = h2[j]; h2[j] = h1[j]; h1[j] = cur[j]; }
                *(u32x4*)(XS + (size_t)row * 3072 + c8) = pack8(acc);
                if (prompt && t >= 2045) { float* o = P.out + OUT_CONVP + ((size_t)b * 3 + (t - 2045)) * 3072 + c8; *(f32x4*)o = (f32x4){cur[0], cur[1], cur[2], cur[3]}; *(f32x4*)(o + 4) = (f32x4){cur[4], cur[5], cur[6], cur[7]}; }
                if (!prompt && t >= 1) { float* o = P.out + OUT_CONVS + ((size_t)b * 3 + (t - 1)) * 3072 + c8; *(f32x4*)o = (f32x4){cur[0], cur[1], cur[2], cur[3]}; *(f32x4*)(o + 4) = (f32x4){cur[4], cur[5], cur[6], cur[7]}; } }
        }
    }
    const float* dtb = P.in[I_SSMDTB];
#pragma unroll 4
    for (int i = gt; i < T * 32; i += NT) DT[i] = softplusf_(DTR[i] + dtb[i & 31]);
}

DI void ssd_scan(const Params& P, LAS unsigned char* lds) {
    const int tid = tid_(), wid = __builtin_amdgcn_readfirstlane(tid >> 6), lane = tid & 63, fr = lane & 15, fq = lane >> 4;
    unsigned char* ws = P.ws;
    const bf16_t* XS = (const bf16_t*)(ws + O_R + R_XBCS); const bf16_t* Z = (const bf16_t*)(ws + O_R + R_Z); const float* DT = (const float*)(ws + O_R + R_DT);
    bf16_t* YB = (bf16_t*)(ws + O_R + R_YBUF); float* SSS = (float*)(ws + O_ST) + ST_SSSP;
    constexpr int SSET = 9216 + 9216 + 17408 + 18432;
    LAS bf16_t* Sb0 = (LAS bf16_t*)(lds + 18432);
    const int mb = wid >> 1, hb = wid & 1;
    for (int it = bid_(); it < 256; it += gdim_()) {
        const int h = it & 31, b = it >> 5, g = h >> 3;
        const float a = -__expf(P.in[I_SSMALOG][h]); const float dsk = P.in[I_SSMD][h];
        f32x4 Sacc[4];
#pragma unroll
        for (int i = 0; i < 4; ++i) Sacc[i] = (f32x4){0.f, 0.f, 0.f, 0.f};
        for (int i = tid; i < 64 * 136 / 2; i += 512) ((LAS unsigned*)Sb0)[i] = 0u;
        float dtv; u32x4 xw, bw[2]; bf16x8 ca[4], bbf[2][4];
#define SSD_LOAD(ROW0, DTV, CA) do { \
            DTV = DT[(size_t)((ROW0) + lane) * 32 + h]; \
            xw = *(const u32x4*)(XS + (size_t)((ROW0) + lane) * 3072 + h * 64 + wid * 8); \
            _Pragma("unroll") for (int i_ = 0; i_ < 2; ++i_) bw[i_] = *(const u32x4*)(XS + (size_t)((ROW0) + lane) * 3072 + 2048 + g * 128 + (wid + 8 * i_) * 8); \
            _Pragma("unroll") for (int ks_ = 0; ks_ < 4; ++ks_) CA[ks_] = *(const bf16x8*)(XS + (size_t)((ROW0) + 16 * mb + fr) * 3072 + 2560 + g * 128 + 32 * ks_ + 8 * fq); \
            _Pragma("unroll") for (int i_ = 0; i_ < 2; ++i_) _Pragma("unroll") for (int ks_ = 0; ks_ < 4; ++ks_) bbf[i_][ks_] = *(const bf16x8*)(XS + (size_t)((ROW0) + 16 * (2 * hb + i_) + fr) * 3072 + 2048 + g * 128 + 32 * ks_ + 8 * fq); } while (0)
        SSD_LOAD(b * 2048, dtv, ca);
        for (int n = 0; n < 32; ++n) {
            const int row0 = b * 2048 + 64 * n;
            LAS unsigned char* sb_ = lds + (n & 1) * SSET; LAS unsigned char* so_ = lds + ((n & 1) ^ 1) * SSET;
            LAS bf16_t* Pm = (LAS bf16_t*)sb_; LAS bf16_t* Xt = (LAS bf16_t*)(sb_ + 9216); LAS bf16_t* Sb = (LAS bf16_t*)(sb_ + 18432); LAS bf16_t* BWt = (LAS bf16_t*)(sb_ + 35840);
            LAS bf16_t* Sbn = (LAS bf16_t*)(so_ + 18432);
            float cum = dtv * a;
#pragma unroll
            for (int of = 1; of < 64; of <<= 1) { const float o = __shfl_up(cum, of); if (lane >= of) cum += o; }
            const float cl = __shfl(cum, 63); const float wend = __expf(cl - cum) * dtv;
            { const int p8 = wid * 8; const bf16_t* e = (const bf16_t*)&xw;
#pragma unroll
              for (int j = 0; j < 8; ++j) Xt[(p8 + j) * 72 + lane] = e[j]; }
#pragma unroll
            for (int i = 0; i < 2; ++i) { const int n8 = (wid + 8 * i) * 8; float f[8]; unpack8(bw[i], f);
#pragma unroll
                for (int j = 0; j < 8; ++j) BWt[(n8 + j) * 72 + lane] = f2bf(f[j] * wend); }
            float cumt[4];
#pragma unroll
            for (int j = 0; j < 4; ++j) cumt[j] = __shfl(cum, 16 * mb + 4 * fq + j);
#pragma unroll
            for (int i = 0; i < 2; ++i) { const int nb = 2 * hb + i; f32x4 sc = {0.f, 0.f, 0.f, 0.f};
#pragma unroll
                for (int ks = 0; ks < 4; ++ks) sc = MFMA16(ca[ks], bbf[i][ks], sc);
                const int s = 16 * nb + fr; const float cums = __shfl(cum, s), dts = __shfl(dtv, s);
#pragma unroll
                for (int j = 0; j < 4; ++j) { const int t = 16 * mb + 4 * fq + j; Pm[t * 72 + s] = f2bf(s <= t ? sc[j] * __expf(cumt[j] - cums) * dts : 0.f); } }
            LDS_BARRIER();
            float dtn = dtv; bf16x8 cn[4];
#pragma unroll
            for (int ks = 0; ks < 4; ++ks) cn[ks] = ca[ks];
            if (n + 1 < 32) SSD_LOAD(row0 + 64, dtn, cn);
            f32x4 yi[2], ye[2];
#pragma unroll
            for (int i = 0; i < 2; ++i) { yi[i] = (f32x4){0.f, 0.f, 0.f, 0.f}; ye[i] = (f32x4){0.f, 0.f, 0.f, 0.f}; }
#pragma unroll
            for (int k2 = 0; k2 < 2; ++k2) { const bf16x8 am = *(const LAS bf16x8*)(Pm + (16 * mb + fr) * 72 + 32 * k2 + 8 * fq);
#pragma unroll
                for (int i = 0; i < 2; ++i) { const bf16x8 bb = *(const LAS bf16x8*)(Xt + (16 * (2 * hb + i) + fr) * 72 + 32 * k2 + 8 * fq); yi[i] = MFMA16(am, bb, yi[i]); } }
#pragma unroll
            for (int ks = 0; ks < 4; ++ks)
#pragma unroll
                for (int i = 0; i < 2; ++i) { const bf16x8 bb = *(const LAS bf16x8*)(Sb + (16 * (2 * hb + i) + fr) * 136 + 32 * ks + 8 * fq); ye[i] = MFMA16(ca[ks], bb, ye[i]); }
#pragma unroll
            for (int j = 0; j < 4; ++j) { const int tl = 16 * mb + 4 * fq + j, row = row0 + tl; const float ec = __expf(cumt[j]);
#pragma unroll
                for (int i = 0; i < 2; ++i) { const int p = 16 * (2 * hb + i) + fr; const float xv = bf2f(Xt[p * 72 + tl]);
                    YB[(size_t)row * 2048 + h * 64 + p] = f2bf(yi[i][j] + ec * ye[i][j] + dsk * xv); } }
            { const float ecl = __expf(cl);
#pragma unroll
              for (int i = 0; i < 4; ++i) Sacc[i] *= ecl; }
#pragma unroll
            for (int k2 = 0; k2 < 2; ++k2) { const bf16x8 am = *(const LAS bf16x8*)(BWt + (16 * wid + fr) * 72 + 32 * k2 + 8 * fq);
#pragma unroll
                for (int i = 0; i < 4; ++i) { const bf16x8 bb = *(const LAS bf16x8*)(Xt + (16 * i + fr) * 72 + 32 * k2 + 8 * fq); Sacc[i] = MFMA16(am, bb, Sacc[i]); } }
#pragma unroll
            for (int i = 0; i < 4; ++i) { u32x2 w; w.x = pk2(Sacc[i][0], Sacc[i][1]); w.y = pk2(Sacc[i][2], Sacc[i][3]); *(LAS u32x2*)(Sbn + (16 * i + fr) * 136 + 16 * wid + 4 * fq) = w; }
            dtv = dtn;
#pragma unroll
            for (int ks = 0; ks < 4; ++ks) ca[ks] = cn[ks];
        }
#undef SSD_LOAD
        float* SO = P.out + OUT_SSMP + ((size_t)(b * 32 + h) * 64) * 128;
#pragma unroll
        for (int i = 0; i < 4; ++i) __builtin_nontemporal_store(Sacc[i], (f32x4*)(SO + (size_t)(16 * i + fr) * 128 + 16 * wid + 4 * fq));
        LDS_BARRIER();
    }
    { const int gw = bid_() * 8 + wid, NW = gdim_() * 8; const int n4 = (lane & 31) * 4, ph = lane >> 5;
      for (int it = gw; it < 4096; it += NW) { const int b = it >> 5, h = it & 31, g = h >> 3;
          const float a = -__expf(P.in[I_SSMALOG][h]); const float dsk = P.in[I_SSMD][h];
          const float* S0 = P.in[I_SSSM] + ((size_t)(b * 32 + h) * 64) * 128 + n4; float* SO = P.out + OUT_SSMS + ((size_t)(b * 32 + h) * 64) * 128 + n4;
#pragma unroll
          for (int half = 0; half < 2; ++half) { f32x4 S[16];
#pragma unroll
              for (int i = 0; i < 16; ++i) S[i] = *(const f32x4*)(S0 + (size_t)(ph + 2 * (16 * half + i)) * 128);
#pragma unroll 1
              for (int t = 0; t < 4; ++t) { const int row = TP + 4 * b + t; const float dtv = DT[(size_t)row * 32 + h]; const float dec = __expf(dtv * a);
                  const u32x2 bw = *(const u32x2*)(XS + (size_t)row * 3072 + 2048 + g * 128 + n4), cw2 = *(const u32x2*)(XS + (size_t)row * 3072 + 2560 + g * 128 + n4);
                  const f32x4 Bv = {bflo(bw.x), bfhi(bw.x), bflo(bw.y), bfhi(bw.y)}, Cv = {bflo(cw2.x), bfhi(cw2.x), bflo(cw2.y), bfhi(cw2.y)}; float ysel = 0.f;
#pragma unroll
                  for (int i = 0; i < 16; ++i) { const int p = ph + 2 * (16 * half + i); const float xv = bf2f(XS[(size_t)row * 3072 + h * 64 + p]);
                      S[i] = S[i] * dec + Bv * (dtv * xv);
                      float yp = (S[i][0] * Cv[0] + S[i][1] * Cv[1]) + (S[i][2] * Cv[2] + S[i][3] * Cv[3]);
                      yp += __shfl_xor(yp, 1); yp += __shfl_xor(yp, 2); yp += __shfl_xor(yp, 4); yp += __shfl_xor(yp, 8); yp += __shfl_xor(yp, 16);
                      ysel = ((lane & 31) == i) ? yp : ysel; }
                  if ((lane & 31) < 16) { const int p = ph + 2 * (16 * half + (lane & 31)); const float xv = bf2f(XS[(size_t)row * 3072 + h * 64 + p]);
                      YB[(size_t)row * 2048 + h * 64 + p] = f2bf(ysel + dsk * xv); } }
#pragma unroll
              for (int i = 0; i < 16; ++i) __builtin_nontemporal_store(S[i], (f32x4*)(SO + (size_t)(ph + 2 * (16 * half + i)) * 128)); } } }
}

DI void ssd_norm(const Params& P) {
    unsigned char* ws = P.ws; const int tid = tid_(), lane = tid & 63; const int gw = bid_() * 8 + (tid >> 6), NW = gdim_() * 8;
    bf16_t* YB = (bf16_t*)(ws + O_R + R_YBUF); const bf16_t* Z = (const bf16_t*)(ws + O_R + R_Z);
#pragma unroll 4
    for (int item = gw; item < T * 4; item += NW) { const size_t off = (size_t)(item >> 2) * 2048 + (item & 3) * 512 + lane * 8;
        const u32x4 yw = *(const u32x4*)(YB + off), zw = *(const u32x4*)(Z + off); float f[8], z[8]; unpack8(yw, f); unpack8(zw, z);
        float sq = 0.f;
#pragma unroll
        for (int j = 0; j < 8; ++j) { f[j] *= siluf_(z[j]); sq += f[j] * f[j]; }
#pragma unroll
        for (int o = 32; o >= 1; o >>= 1) sq += __shfl_xor(sq, o);
        const float rs = rs_of(sq, 1.f / 512.f);
#pragma unroll
        for (int j = 0; j < 8; ++j) f[j] *= rs;
        *(u32x4*)(YB + off) = pack8(f); }
}

DI void final_norm(const Params& P) {
    unsigned char* ws = P.ws; const int gt = bid_() * 512 + tid_(), NT = gdim_() * 512;
    const float* X = (const float*)(ws + O_X); const float* SS = (const float*)(ws + O_ST); const float* g = P.in[I_NFIN];
#pragma unroll 4
    for (int i = gt; i < T * 256; i += NT) { const int row = i >> 8, c4 = (i & 255) * 4; const float rs = rs_of(sum16(SS + (size_t)row * 16), 1.f / 1024.f);
        const f32x4 v = *(const f32x4*)(X + (size_t)row * DM + c4) * *(const f32x4*)(g + c4) * rs; __builtin_nontemporal_store(v, (f32x4*)(P.out + OUT_Y + (size_t)row * DM + c4)); }
}

__constant__ unsigned char PH_KIND[NPHASES] = { K_P0,
    K_A, K_B, K_GM1, K_GM2, K_GM3, K_D, K_E, K_PP, K_F,
    K_A, K_B, K_PL1, K_PL2, K_D, K_E, K_PP, K_F,
    K_A, K_B, K_GL1, K_GL2, K_GL3, K_GL4, K_GL5, K_D, K_E, K_PP, K_F,
    K_A, K_B, K_SS1, K_SS2, K_SS3, K_SS4, K_SS5, K_D, K_E, K_PP, K_F,
    K_FIN };
__constant__ unsigned char PH_LAYER[NPHASES] = { 0, 0, 0, 0, 0, 0, 0, 0, 0, 0, 1, 1, 1, 1, 1, 1, 1, 1, 2, 2, 2, 2, 2, 2, 2, 2, 2, 2, 2, 3, 3, 3, 3, 3, 3, 3, 3, 3, 3, 3, 3 };

DI void run_phase(const Params& P, int ph, LAS unsigned char* lds) {
    const int kind = PH_KIND[ph], l = PH_LAYER[ph]; unsigned char* ws = P.ws;
    GemmD g; bool is_gemm = true;
    g.A = (const bf16_t*)(ws + O_XB); g.lda = 1024; g.ldb = 1024; g.a_pn_off = 0; g.nM = 66; g.nN = 4; g.K = 1024; g.Bt = nullptr;
    switch (kind) {
    case K_A: case K_D: g.Bt = (const bf16_t*)(ws + (kind == K_A ? O_W1 : O_W2) + (size_t)l * SZ_W1); g.nN = 22; if (kind == K_A && l > 0) g.A = (const bf16_t*)(ws + O_XB2); break;
    case K_B: case K_E: g.A = (const bf16_t*)(ws + O_R + R_ACT); g.lda = FF; g.ldb = FF; g.K = FF; g.Bt = (const bf16_t*)(ws + (kind == K_B ? O_D1 : O_D2) + (size_t)l * SZ_D1); break;
    case K_PP: g.A = (const bf16_t*)(ws + O_PBF); g.lda = 256; g.ldb = 256; g.K = 256; g.Bt = (const bf16_t*)(ws + O_PPW + (size_t)l * SZ_PPW); break;
    case K_F: g.Bt = (const bf16_t*)(ws + O_PG + (size_t)l * SZ_SQ); break;
    case K_GM1: g.Bt = (const bf16_t*)(ws + O_GMIN); g.nN = 8; break;
    case K_GM3: g.A = (const bf16_t*)(ws + O_R + R_GU); g.Bt = (const bf16_t*)(ws + O_GMOUT); break;
    case K_PL2: g.A = (const bf16_t*)(ws + O_R + R_DIFF); g.a_pn_off = 256; g.ldb = 256; g.K = 256; g.Bt = (const bf16_t*)(ws + O_POOLW); break;
    case K_GL1: g.Bt = (const bf16_t*)(ws + O_GLAIN); g.nN = 13; break;
    case K_GL5: g.A = (const bf16_t*)(ws + O_R + R_OBUF); g.Bt = (const bf16_t*)(ws + O_GLAOUT); break;
    case K_SS1: g.Bt = (const bf16_t*)(ws + O_SSMIN); g.nN = 21; break;
    case K_SS5: g.A = (const bf16_t*)(ws + O_R + R_YBUF); g.lda = 2048; g.ldb = 2048; g.K = 2048; g.Bt = (const bf16_t*)(ws + O_SSMOUT); break;
    default: is_gemm = false; break;
    }
    if (is_gemm) {
        const bool mini = (g.nN == 4);
        if (mini) g.nM = 64;
        gemm_phase(lds, g, kind, l);
        if (mini) mini_gemm(lds, g, kind, l);
        if (kind == K_A) conv_p(fresh_params(), l);
        return; }
    switch (kind) {
    case K_P0: phase0(P, lds); break;
    case K_GM2: gm_spatial(P, lds); break;
    case K_PL1: pool_prep(P, lds); break;
    case K_GL2: gla_prep(P, lds); break;
    case K_GL3: gla_scan(P, lds); break;
    case K_GL4: gla_gate(P); break;
    case K_SS2: ssd_conv(P); break;
    case K_SS3: ssd_scan(P, lds); break;
    case K_SS4: ssd_norm(P); break;
    case K_FIN: final_norm(P); break;
    default: break;
    }
}


#define XB_TMO      128
#define XB_XCNT(j)  (256  + 64 * (j))
#define XB_XSUB(j)  (1280 + 64 * (j))
#define XB_XGEN(j)  (2304 + 64 * (j))
#define XB_TOP      3328
#define XB_TOPGEN   3392
#define XCD_BAR_WORDS 3456
#define XB_SPIN_CAP (1u << 18)
__device__ __forceinline__ unsigned xb_ld(unsigned* p)              { return __hip_atomic_load(p, __ATOMIC_RELAXED, __HIP_MEMORY_SCOPE_AGENT); }
__device__ __forceinline__ unsigned xb_add(unsigned* p, unsigned v) { return __hip_atomic_fetch_add(p, v, __ATOMIC_RELAXED, __HIP_MEMORY_SCOPE_AGENT); }
__device__ __forceinline__ unsigned xb_xcc_id() { return (unsigned)__builtin_amdgcn_s_getreg((3 << 11) | 20) & 0xFu; }
#define XB_SPIN(cond, bar) do { unsigned _sp = 0; while (cond) { __builtin_amdgcn_s_sleep(1); \
    if ((++_sp & 255u) == 0u) { if (xb_ld(&(bar)[XB_TMO])) break; if (_sp > XB_SPIN_CAP) { atomicAdd(&(bar)[XB_TMO], 1u); break; } } } } while (0)
struct XcdBarrier { unsigned* bar; unsigned x; volatile LAS unsigned* st; };
__device__ __forceinline__ XcdBarrier xcd_barrier_post(unsigned* bar, volatile LAS unsigned* st) {
    XcdBarrier b; b.bar = bar; b.x = xb_xcc_id(); b.st = st;
    if (threadIdx.x == 0) (void)xb_add(&bar[XB_XCNT(b.x)], 1u);
    return b;
}
__device__ __forceinline__ void xcd_barrier_complete(unsigned* bar, unsigned x, unsigned& nloc, unsigned& nx) {
    const unsigned G = gridDim.x * gridDim.y * gridDim.z;
    unsigned sum, cnt, mine, sp = 0u;
    for (;;) {
        sum = 0u; cnt = 0u; mine = 0u;
#pragma unroll
        for (unsigned j = 0; j < 16; ++j) { const unsigned c = xb_ld(&bar[XB_XCNT(j)]); sum += c; cnt += (c > 0u) ? 1u : 0u; mine = (j == x) ? c : mine; }
        if (sum == G) break;
        __builtin_amdgcn_s_sleep(1);
        if ((++sp & 255u) == 0u) { if (xb_ld(&bar[XB_TMO])) break; if (sp > XB_SPIN_CAP) { atomicAdd(&bar[XB_TMO], 1u); break; } }
    }
    nloc = mine > 0u ? mine : 1u; nx = cnt > 0u ? cnt : 1u;
}
__device__ __forceinline__ void xcd_barrier(const XcdBarrier& b) {
    asm volatile("s_waitcnt vmcnt(0)" ::: "memory");
    __syncthreads();
    if (threadIdx.x == 0) {
        unsigned* bar = b.bar;
        __builtin_amdgcn_s_waitcnt(0);
        unsigned nloc = b.st[0], nx = b.st[1];
        if (nloc == 0u) { xcd_barrier_complete(bar, b.x, nloc, nx); b.st[0] = nloc; b.st[1] = nx; }
        const unsigned old = xb_add(&bar[XB_XSUB(b.x)], 1u);
        const unsigned gen = old / nloc;
        if (old + 1u == (gen + 1u) * nloc) {
            __builtin_amdgcn_fence(__ATOMIC_RELEASE, "agent");
            asm volatile("s_waitcnt vmcnt(0)" ::: "memory");
            const unsigned og = xb_add(&bar[XB_TOP], 1u);
            const unsigned tg = og / nx;
            if (og + 1u == (tg + 1u) * nx) xb_add(&bar[XB_TOPGEN], 1u);
            else XB_SPIN(xb_ld(&bar[XB_TOPGEN]) == tg, bar);
            __builtin_amdgcn_fence(__ATOMIC_ACQUIRE, "agent");
            xb_add(&bar[XB_XGEN(b.x)], 1u);
            asm volatile("s_waitcnt vmcnt(0)" ::: "memory");
        } else {
            XB_SPIN(xb_ld(&bar[XB_XGEN(b.x)]) == gen, bar);
            __builtin_amdgcn_fence(__ATOMIC_ACQUIRE, "agent");
            asm volatile("s_waitcnt vmcnt(0)" ::: "memory");
        }
    }
    __syncthreads();
}

__global__ void __launch_bounds__(512, 2) mega(Params P, int ph_lo, int ph_hi) {
    extern __shared__ __attribute__((aligned(16))) unsigned char smem[];
    LAS unsigned char* lds = (LAS unsigned char*)smem;
    if (ph_lo > ph_hi) cg::this_grid().sync();
    volatile LAS unsigned* st = (volatile LAS unsigned*)(lds + 131072);
    if (threadIdx.x < 2) st[threadIdx.x] = 0u;
    __syncthreads();
    const XcdBarrier bar = xcd_barrier_post((unsigned*)(P.ws + O_BAR), st);
    for (int ph = ph_lo; ph < ph_hi; ++ph) {
        if (ph > ph_lo) xcd_barrier(bar);
        run_phase(fresh_params(), ph, lds);
    }
}

constexpr int LDS_BYTES = 131072 + 16;

extern "C" void kernel_launch(void* const* d_in, const int* in_sizes, int n_in, void* d_out, int out_size, void* d_ws, size_t ws_size, hipStream_t stream) {
    static int grid = 0;
    if (grid == 0) {
        if (n_in != N_IN || ws_size < WS_TOTAL) { fprintf(stderr, "kernel_launch: n_in %d (want %d), ws %zu (want >= %zu)\n", n_in, (int)N_IN, ws_size, (size_t)WS_TOTAL); grid = -1; return; }
        int dev = 0, cus = 0, per_cu = 0;
        hipGetDevice(&dev); hipDeviceGetAttribute(&cus, hipDeviceAttributeMultiprocessorCount, dev);
        if (hipFuncSetAttribute((const void*)mega, hipFuncAttributeMaxDynamicSharedMemorySize, LDS_BYTES) != hipSuccess) { fprintf(stderr, "kernel_launch: hipFuncSetAttribute failed\n"); grid = -1; return; }
        if (hipOccupancyMaxActiveBlocksPerMultiprocessor(&per_cu, (const void*)mega, 512, LDS_BYTES) != hipSuccess || per_cu < 1) { fprintf(stderr, "kernel_launch: occupancy query says %d\n", per_cu); per_cu = 1; }
        (void)hipGetLastError();
        grid = cus;
    }
    if (grid < 0) return;
    if (hipMemsetAsync((char*)d_ws + O_BAR, 0, 16384, stream) != hipSuccess) { fprintf(stderr, "kernel_launch: memset of the barrier words failed\n"); return; }
    Params p{};
    for (int i = 0; i < N_IN; ++i) p.in[i] = (const float*)d_in[i];
    p.out = (float*)d_out; p.ws = (unsigned char*)d_ws;
    int lo = 0, hi = NPHASES;
    void* args[] = {&p, &lo, &hi};
    hipError_t e = hipLaunchCooperativeKernel((const void*)mega, dim3(grid), dim3(512), args, LDS_BYTES, stream);
    if (e != hipSuccess) fprintf(stderr, "kernel_launch: cooperative launch failed: %s (grid %d)\n", hipGetErrorString(e), grid);
}
```

```cpp
#include <hip/hip_runtime.h>
#include <hip/hip_cooperative_groups.h>
#include <cstdio>
#include <cstdint>
namespace cg = cooperative_groups;

#define LAS __attribute__((address_space(3)))
#define DI __device__ __forceinline__
typedef unsigned short bf16_t;
typedef short bf16x8 __attribute__((ext_vector_type(8)));
typedef float f32x4 __attribute__((ext_vector_type(4)));
typedef unsigned u32x4 __attribute__((ext_vector_type(4)));
typedef unsigned u32x2 __attribute__((ext_vector_type(2)));

constexpr int T = 16896, TP = 16384, DM = 1024, FF = 2816;
constexpr float EPS = 1e-6f;
constexpr int NPHASES = 41;

constexpr size_t SZ_W1 = (size_t)5632 * 1024 * 2, SZ_D1 = (size_t)1024 * 2816 * 2, SZ_SQ = (size_t)1024 * 1024 * 2, SZ_PPW = (size_t)1024 * 256 * 2;
constexpr size_t O_W1 = 0;
constexpr size_t O_D1 = O_W1 + 4 * SZ_W1;
constexpr size_t O_W2 = O_D1 + 4 * SZ_D1;
constexpr size_t O_D2 = O_W2 + 4 * SZ_W1;
constexpr size_t O_PG = O_D2 + 4 * SZ_D1;
constexpr size_t O_PPW = O_PG + 4 * SZ_SQ;
constexpr size_t O_GMIN = O_PPW + 4 * SZ_PPW;
constexpr size_t O_GMOUT = O_GMIN + (size_t)2048 * 1024 * 2;
constexpr size_t O_POOLW = O_GMOUT + SZ_SQ;
constexpr size_t O_GLAIN = O_POOLW + (size_t)1024 * 256 * 2;
constexpr size_t O_GLAOUT = O_GLAIN + (size_t)3328 * 1024 * 2;
constexpr size_t O_SSMIN = O_GLAOUT + SZ_SQ;
constexpr size_t O_SSMOUT = O_SSMIN + (size_t)5376 * 1024 * 2;
constexpr size_t O_WSB = O_SSMOUT + (size_t)1024 * 2048 * 2;
constexpr size_t O_X = O_WSB + (size_t)8 * 128 * 128 * 2;
constexpr size_t O_XB = O_X + (size_t)T * 1024 * 4;
constexpr size_t O_ST = O_XB + (size_t)T * 1024 * 2;
constexpr size_t O_PBF = O_ST + (size_t)192 * T * 4;
constexpr size_t ST_GSP = (size_t)32 * T, ST_GSSP = (size_t)64 * T, ST_SSSP = (size_t)128 * T;
constexpr size_t O_PP = O_PBF + (size_t)T * 256 * 2;
constexpr size_t O_XB2 = O_PP + (size_t)T * 1024 * 2;
constexpr size_t O_R = O_XB2 + (size_t)T * 1024 * 2;
constexpr size_t R_ACT = 0;
constexpr size_t R_U = 0, R_V = R_U + (size_t)T * 1024 * 2, R_GU = R_V + (size_t)T * 1024 * 2;
constexpr size_t R_DIFF = 0;
constexpr size_t R_QKVR = 0, R_T16 = R_QKVR + (size_t)T * 3072 * 2, R_QD = R_T16 + (size_t)T * 16 * 4, R_KI = R_QD + (size_t)T * 512 * 2,
                 R_DEC = R_KI + (size_t)T * 512 * 2, R_SA = R_DEC + (size_t)256 * 512 * 4, R_OBUF = R_SA + (size_t)512 * 512 * 4;
constexpr size_t R_Z = 0, R_XBC = R_Z + (size_t)T * 2048 * 2, R_XBCS = R_XBC + (size_t)T * 3072 * 2, R_DTR = R_XBCS + (size_t)T * 3072 * 2,
                 R_DT = R_DTR + (size_t)T * 32 * 4, R_END = R_DT + (size_t)T * 32 * 4;
constexpr size_t R_YBUF = R_XBC;
constexpr size_t O_BAR = O_R + R_END;
constexpr size_t WS_TOTAL = O_BAR + 16384;
constexpr size_t OUT_Y = 0, OUT_CV = 17301504, OUT_POOLP = 17825792, OUT_POOLS = 17948672, OUT_GLAP = 19914752, OUT_GLAS = 20963328,
                 OUT_SSMP = 37740544, OUT_SSMS = 39837696, OUT_CONVP = 73392128, OUT_CONVS = 73465856;

enum { I_XP = 0, I_XS, I_SPOOL, I_SGLA, I_SSSM, I_SCONV, I_PP, I_PS, I_NF1, I_F1G, I_F1U, I_F1D, I_NMIX, I_NF2, I_F2G, I_F2U, I_F2D, I_NPLE, I_PLEG, I_PLEP,
       I_NFIN, I_GMIN, I_GMLN, I_GMWS, I_GMBS, I_GMOUT, I_POOLW, I_POOLSC, I_GLAIN, I_GLAA1, I_GLAA2, I_GLABA, I_GLANORM, I_GLAOUT, I_SSMIN, I_SSMCW, I_SSMCB,
       I_SSMDTB, I_SSMALOG, I_SSMD, I_SSMNORM, I_SSMOUT, N_IN };

struct Params { const float* in[N_IN]; float* out; unsigned char* ws; };
__device__ __forceinline__ const Params& fresh_params() {
    auto kp = __builtin_amdgcn_kernarg_segment_ptr();
    asm volatile("" : "+s"(kp));
    return *(const Params*)kp;
}

__device__ __forceinline__ int tid_() { int t = (int)threadIdx.x; asm volatile("" : "+v"(t)); return t & 511; }
__device__ __forceinline__ int bid_() { int b = (int)blockIdx.x; asm volatile("" : "+s"(b)); return b; }
__device__ __forceinline__ int gdim_() { int g = (int)gridDim.x; asm volatile("" : "+s"(g)); return g; }
typedef float f32x2v __attribute__((ext_vector_type(2)));
typedef __bf16 bf16x2v __attribute__((ext_vector_type(2)));
DI unsigned pk2(float lo, float hi) { const f32x2v v = {lo, hi}; const bf16x2v b = __builtin_convertvector(v, bf16x2v); return __builtin_bit_cast(unsigned, b); }
DI float bflo(unsigned w) { return __uint_as_float(w << 16); }
DI float bfhi(unsigned w) { return __uint_as_float(w & 0xffff0000u); }
DI float bf2f(bf16_t b) { return __uint_as_float(((unsigned)b) << 16); }
DI bf16_t f2bf(float f) { return (bf16_t)(pk2(f, 0.f) & 0xffffu); }
DI float sigmoidf_(float x) { return __builtin_amdgcn_rcpf(1.0f + __expf(-x)); }
DI float siluf_(float x) { return x * sigmoidf_(x); }
DI float geluf_(float x) { return x * sigmoidf_(1.5957691216f * (x + 0.044715f * x * x * x)); }
DI float softplusf_(float x) { return fmaxf(x, 0.f) + __logf(1.0f + __expf(-fabsf(x))); }
DI void unpack8(const u32x4& w, float* f) { f[0] = bflo(w.x); f[1] = bfhi(w.x); f[2] = bflo(w.y); f[3] = bfhi(w.y); f[4] = bflo(w.z); f[5] = bfhi(w.z); f[6] = bflo(w.w); f[7] = bfhi(w.w); }
DI u32x4 pack8(const float* f) { u32x4 w; w.x = pk2(f[0], f[1]); w.y = pk2(f[2], f[3]); w.z = pk2(f[4], f[5]); w.w = pk2(f[6], f[7]); return w; }
DI float rs_of(float ss, float inv_n) { return __builtin_amdgcn_rsqf(ss * inv_n + EPS); }
DI void atomic_add_f32(float* p, float v) {
    [[clang::atomic(no_remote_memory, no_fine_grained_memory, ignore_denormal_mode)]] { (void)__hip_atomic_fetch_add(p, v, __ATOMIC_RELAXED, __HIP_MEMORY_SCOPE_AGENT); }
}
DI float sum16(const float* p) { const f32x4 a = *(const f32x4*)p, b = *(const f32x4*)(p + 4), c = *(const f32x4*)(p + 8), d = *(const f32x4*)(p + 12); const f32x4 s = (a + b) + (c + d); return (s[0] + s[1]) + (s[2] + s[3]); }
#define LDS_BARRIER() do { asm volatile("s_waitcnt lgkmcnt(0)" ::: "memory"); __builtin_amdgcn_s_barrier(); asm volatile("" ::: "memory"); } while (0)
DI float sum16_fq(const float* p, int fq) { const f32x4 a = *(const f32x4*)(p + 4 * fq); float s = (a[0] + a[1]) + (a[2] + a[3]); s += __shfl_xor(s, 16); s += __shfl_xor(s, 32); return s; }
#define MFMA16(a, b, c) __builtin_amdgcn_mfma_f32_16x16x32_bf16((a), (b), (c), 0, 0, 0)

constexpr int BM = 256, BK = 64, HALF = 128, HTB = HALF * BK * 2;
DI int lds_byte(int r, int c) { const int st = (r >> 4) * 2 + (c >> 5), rr = r & 15, cc = c & 31, ob = rr * 64 + cc * 2; return st * 1024 + (ob ^ (((ob >> 9) & 1) << 5)); }
DI void stage_rc(int b, int& R, int& C) { const int st = b / 1024, sb = b % 1024, swz = sb ^ (((sb >> 9) & 1) << 5); R = (st >> 1) * 16 + swz / 64; C = (st & 1) * 32 + (swz % 64) / 2; }
DI int perm32(int rho) { const int n = rho >> 4, i = rho & 15; return 8 * (i >> 2) + 4 * n + (i & 3); }

enum { K_P0 = 0, K_A, K_B, K_D, K_E, K_PP, K_F, K_GM1, K_GM2, K_GM3, K_PL1, K_PL2, K_GL1, K_GL2, K_GL3, K_GL4, K_GL5, K_SS1, K_SS2, K_SS3, K_SS4, K_SS5, K_FIN, K_NOP };
struct Unit { int pm, pn; };
struct GemmD { const bf16_t* A; const bf16_t* Bt; int lda, ldb, a_pn_off, nM, nN, K; };
enum { EM_SWIGLU = 0, EM_RESID, EM_PLE, EM_PLAIN, EM_GMIN, EM_GLAIN, EM_SSMIN };
struct EpiD { int mode; float alpha; const float* xin; float* x; bf16_t* xb; const float* ss_in; float* ss_out; bf16_t* o0; bf16_t* o1; float* f0; const float* cs; const bf16_t* ppb; };

DI bool unit_at(const GemmD& g, int i, int G, int c, Unit& u) {
    const int nwg = g.nM * g.nN; const long L = (long)i * G + c; if (L >= nwg) return false;
    int wgid = (int)L; { const int q = nwg / 8, r = nwg % 8, xcd = wgid % 8, off = wgid / 8; wgid = (xcd < r ? xcd * (q + 1) : r * (q + 1) + (xcd - r) * q) + off; }
    const int nig = 8 * g.nN, gid = wgid / nig, fm = gid * 8, gsz = (g.nM - fm) < 8 ? (g.nM - fm) : 8;
    u.pm = fm + ((wgid % nig) % gsz); u.pn = (wgid % nig) / gsz; return true;
}

DI EpiD make_epi(int kind, int l, bool mini = false);
DI void epilogue(int kind, int l, const f32x4 (&acc)[2][2][4][2], const Unit& u, int wr, int wc, int fr, int fq) {
    const EpiD E = make_epi(kind, l);
    const int row0 = u.pm * BM + wr * 64 + fr, col0 = u.pn * BM + wc * 32 + 8 * fq;
    if (E.mode == EM_SWIGLU) {
#pragma unroll
        for (int ai = 0; ai < 2; ++ai)
#pragma unroll
            for (int m = 0; m < 4; ++m) { const int row = row0 + ai * HALF + m * 16; const float rs = rs_of(sum16_fq(E.ss_in + (size_t)row * 16, fq), 1.f / 1024.f);
#pragma unroll
                for (int bj = 0; bj < 2; ++bj) { const f32x4 g = acc[ai][bj][m][0] * rs, up = acc[ai][bj][m][1] * rs;
                    u32x2 w; w.x = pk2(siluf_(g[0]) * up[0], siluf_(g[1]) * up[1]); w.y = pk2(siluf_(g[2]) * up[2], siluf_(g[3]) * up[3]);
                    *(u32x2*)(E.o0 + (size_t)row * FF + ((col0 + bj * HALF) >> 1)) = w; } }
    } else if (E.mode == EM_RESID || E.mode == EM_PLE) {
        const bool ple = E.mode == EM_PLE;
#pragma unroll
        for (int ai = 0; ai < 2; ++ai)
#pragma unroll
            for (int m = 0; m < 4; ++m) { const int row = row0 + ai * HALF + m * 16; float sq = 0.f;
                const float rs = ple ? rs_of(sum16_fq(E.ss_in + (size_t)row * 16, fq), 1.f / 1024.f) : 0.f;
#pragma unroll
                for (int bj = 0; bj < 2; ++bj) { const int col = col0 + bj * HALF; float* xp = E.x + (size_t)row * DM + col; const float* xi = E.xin + (size_t)row * DM + col;
                    f32x4 x0 = *(const f32x4*)xi, x1 = *(const f32x4*)(xi + 4); f32x4 v0 = acc[ai][bj][m][0], v1 = acc[ai][bj][m][1];
                    if (ple) { const u32x4 pw = *(const u32x4*)(E.ppb + (size_t)row * DM + col); float pf[8]; unpack8(pw, pf);
#pragma unroll
                        for (int j = 0; j < 4; ++j) { x0[j] += sigmoidf_(v0[j] * rs) * pf[j] * E.alpha; x1[j] += sigmoidf_(v1[j] * rs) * pf[4 + j] * E.alpha; }
                    } else if (E.cs) { const f32x4 c0 = *(const f32x4*)(E.cs + col), c1 = *(const f32x4*)(E.cs + col + 4); x0 += v0 * c0 * E.alpha; x1 += v1 * c1 * E.alpha; }
                    else { x0 += v0 * E.alpha; x1 += v1 * E.alpha; }
                    *(f32x4*)xp = x0; *(f32x4*)(xp + 4) = x1;
                    u32x4 w; w.x = pk2(x0[0], x0[1]); w.y = pk2(x0[2], x0[3]); w.z = pk2(x1[0], x1[1]); w.w = pk2(x1[2], x1[3]);
                    *(u32x4*)(E.xb + (size_t)row * DM + col) = w;
                    sq += (x0[0] * x0[0] + x0[1] * x0[1]) + (x0[2] * x0[2] + x0[3] * x0[3]) + (x1[0] * x1[0] + x1[1] * x1[1]) + (x1[2] * x1[2] + x1[3] * x1[3]); }
                sq += __shfl_xor(sq, 16); sq += __shfl_xor(sq, 32);
                if (fq == 0) E.ss_out[(size_t)row * 16 + u.pn * 4 + wc] = sq; }
    } else if (E.mode == EM_PLAIN) {
#pragma unroll
        for (int ai = 0; ai < 2; ++ai)
#pragma unroll
            for (int m = 0; m < 4; ++m) { const int row = row0 + ai * HALF + m * 16;
#pragma unroll
                for (int bj = 0; bj < 2; ++bj) { const f32x4 v0 = acc[ai][bj][m][0], v1 = acc[ai][bj][m][1];
                    u32x4 w; w.x = pk2(v0[0], v0[1]); w.y = pk2(v0[2], v0[3]); w.z = pk2(v1[0], v1[1]); w.w = pk2(v1[2], v1[3]);
                    *(u32x4*)(E.o0 + (size_t)row * DM + col0 + bj * HALF) = w; } }
    } else if (E.mode == EM_GMIN) {
        const bool isv = u.pn >= 4;
#pragma unroll
        for (int ai = 0; ai < 2; ++ai)
#pragma unroll
            for (int m = 0; m < 4; ++m) { const int row = row0 + ai * HALF + m * 16; const float rs = rs_of(sum16_fq(E.ss_in + (size_t)row * 16, fq), 1.f / 1024.f); float s1 = 0.f, s2 = 0.f;
#pragma unroll
                for (int bj = 0; bj < 2; ++bj) { const int col = col0 + bj * HALF; float v[8];
#pragma unroll
                    for (int j = 0; j < 4; ++j) { v[j] = geluf_(acc[ai][bj][m][0][j] * rs); v[4 + j] = geluf_(acc[ai][bj][m][1][j] * rs); }
                    const u32x4 w = pack8(v);
                    if (isv) { *(u32x4*)(E.o1 + (size_t)row * DM + col - 1024) = w;
#pragma unroll
                        for (int j = 0; j < 8; ++j) { s1 += v[j]; s2 += v[j] * v[j]; } }
                    else *(u32x4*)(E.o0 + (size_t)row * DM + col) = w; }
                if (isv) { s1 += __shfl_xor(s1, 16); s1 += __shfl_xor(s1, 32); s2 += __shfl_xor(s2, 16); s2 += __shfl_xor(s2, 32);
                    if (fq == 0) { float* gp = E.f0 + (size_t)row * 32 + ((u.pn - 4) * 4 + wc) * 2; gp[0] = s1; gp[1] = s2; } } }
    } else if (E.mode == EM_GLAIN) {
#pragma unroll
        for (int ai = 0; ai < 2; ++ai)
#pragma unroll
            for (int m = 0; m < 4; ++m) { const int row = row0 + ai * HALF + m * 16; float rs = rs_of(sum16_fq(E.ss_in + (size_t)row * 16, fq), 1.f / 1024.f);
                if (u.pn < 2) rs *= 0.08838834764831845f;
#pragma unroll
                for (int bj = 0; bj < 2; ++bj) { const int col = col0 + bj * HALF; const f32x4 v0 = acc[ai][bj][m][0] * rs, v1 = acc[ai][bj][m][1] * rs;
                    if (col < 3072) { u32x4 w; w.x = pk2(v0[0], v0[1]); w.y = pk2(v0[2], v0[3]); w.z = pk2(v1[0], v1[1]); w.w = pk2(v1[2], v1[3]);
                        *(u32x4*)(E.o0 + (size_t)row * 3072 + col) = w; }
                    else if (col < 3088) { float* tp = E.f0 + (size_t)row * 16 + (col - 3072); *(f32x4*)tp = v0; *(f32x4*)(tp + 4) = v1; } } }
    } else {
#pragma unroll
        for (int ai = 0; ai < 2; ++ai)
#pragma unroll
            for (int m = 0; m < 4; ++m) { const int row = row0 + ai * HALF + m * 16; const float rs = rs_of(sum16_fq(E.ss_in + (size_t)row * 16, fq), 1.f / 1024.f);
#pragma unroll
                for (int bj = 0; bj < 2; ++bj) { const int col = col0 + bj * HALF; const f32x4 v0 = acc[ai][bj][m][0] * rs, v1 = acc[ai][bj][m][1] * rs;
                    if (col < 5120) { u32x4 w; w.x = pk2(v0[0], v0[1]); w.y = pk2(v0[2], v0[3]); w.z = pk2(v1[0], v1[1]); w.w = pk2(v1[2], v1[3]);
                        if (col < 2048) *(u32x4*)(E.o0 + (size_t)row * 2048 + col) = w; else *(u32x4*)(E.o1 + (size_t)row * 3072 + (col - 2048)) = w; }
                    else if (col < 5152) { float* tp = E.f0 + (size_t)row * 32 + (col - 5120); *(f32x4*)tp = v0; *(f32x4*)(tp + 4) = v1; } } }
    }
}

DI EpiD make_epi(int kind, int l, bool mini) {
    const Params& P = fresh_params(); unsigned char* ws = P.ws;
    float* ST = (float*)(ws + O_ST);
    EpiD e; e.mode = EM_RESID; e.alpha = 1.f; e.x = (float*)(ws + O_X); e.xin = e.x; e.xb = (bf16_t*)(ws + O_XB); e.ss_in = nullptr; e.ss_out = nullptr; e.o0 = nullptr; e.o1 = nullptr; e.f0 = nullptr; e.cs = nullptr; e.ppb = nullptr;
    switch (kind) {
    case K_A: case K_D: e.mode = EM_SWIGLU; e.ss_in = ST; e.o0 = (bf16_t*)(ws + O_R + R_ACT); break;
    case K_B: case K_E: e.alpha = 0.5f; e.ss_out = ST + (size_t)16 * T;
        if (kind == K_B && l == 0) e.xin = mini ? P.in[I_XS] - (size_t)TP * DM : P.in[I_XP];
        break;
    case K_PP: e.mode = EM_PLAIN; e.o0 = (bf16_t*)(ws + O_PP); break;
    case K_F: e.mode = EM_PLE; e.xb = (bf16_t*)(ws + O_XB2); e.ss_in = ST + (size_t)16 * T; e.ss_out = ST; e.ppb = (const bf16_t*)(ws + O_PP); break;
    case K_GM1: e.mode = EM_GMIN; e.ss_in = ST + (size_t)16 * T; e.o0 = (bf16_t*)(ws + O_R + R_U); e.o1 = (bf16_t*)(ws + O_R + R_V); e.f0 = ST + ST_GSP; break;
    case K_GM3: e.ss_out = ST; break;
    case K_PL2: e.cs = P.in[I_POOLSC]; e.ss_out = ST; break;
    case K_GL1: e.mode = EM_GLAIN; e.ss_in = ST + (size_t)16 * T; e.o0 = (bf16_t*)(ws + O_R + R_QKVR); e.f0 = (float*)(ws + O_R + R_T16); break;
    case K_GL5: e.ss_out = ST; break;
    case K_SS1: e.mode = EM_SSMIN; e.ss_in = ST + (size_t)16 * T; e.o0 = (bf16_t*)(ws + O_R + R_Z); e.o1 = (bf16_t*)(ws + O_R + R_XBC); e.f0 = (float*)(ws + O_R + R_DTR); break;
    default: e.ss_out = ST; break;
    }
    return e;
}

DI void gemm_phase(LAS unsigned char* lds, const GemmD g, const int kind, const int l) {
    const int tid = tid_(), wid = __builtin_amdgcn_readfirstlane(tid >> 6), lane = tid & 63, wr = wid >> 2, wc = wid & 3, fr = lane & 15, fq = lane >> 4;
    const int K = g.K, nt = K / BK; const int G = gdim_(), c = bid_();
    unsigned voffA[2], voffB[2];
#pragma unroll
    for (int i = 0; i < 2; ++i) { int R, C; stage_rc(tid * 16 + i * 8192, R, C); const int Rb = (R & ~31) + perm32(R & 31);
        voffA[i] = (unsigned)(R * g.lda + C) * 2u; voffB[i] = (unsigned)(Rb * g.ldb + C) * 2u; }
    const size_t kstep = (size_t)(BK * 2);
    const size_t hstepA = (size_t)HALF * g.lda * 2, hstepB = (size_t)HALF * g.ldb * 2;
    const size_t tstepA = 2 * hstepA, tstepB = 2 * hstepB, pnA = (size_t)g.a_pn_off * 2;
    const unsigned ldsw = (unsigned)wid * 1024u;
    const int aoff = lds_byte(wr * 64 + fr, fq * 8), boff = lds_byte(wc * 32 + fr, fq * 8);
#define PG8_SA(b, h) (((b) * 2 + (h)) * HTB)
#define PG8_SB(b, h) ((4 + (b) * 2 + (h)) * HTB)
#define PG8_STAGE(bufoff, gbase, voff) do { _Pragma("unroll") for (int _i = 0; _i < 2; ++_i) \
        __builtin_amdgcn_global_load_lds((const unsigned*)((const char*)(gbase) + (voff)[_i]), (LAS unsigned*)(lds + (bufoff) + ldsw + _i * 8192), 16, 0, 0); } while (0)
#define PG8_LDA(dst, b, h) do { _Pragma("unroll") for (int m = 0; m < 4; ++m) _Pragma("unroll") for (int k = 0; k < 2; ++k) dst[m][k] = *(const LAS bf16x8*)(lds + PG8_SA(b, h) + aoff + m * 2048 + k * 1024); } while (0)
#define PG8_LDB(dst, b, h) do { _Pragma("unroll") for (int n = 0; n < 2; ++n) _Pragma("unroll") for (int k = 0; k < 2; ++k) dst[n][k] = *(const LAS bf16x8*)(lds + PG8_SB(b, h) + boff + n * 2048 + k * 1024); } while (0)
#define PG8_MMA(ai, bj, At, Bt) do { __builtin_amdgcn_s_setprio(1); _Pragma("unroll") for (int m = 0; m < 4; ++m) _Pragma("unroll") for (int n = 0; n < 2; ++n) _Pragma("unroll") for (int k = 0; k < 2; ++k) \
        acc[ai][bj][m][n] = __builtin_amdgcn_mfma_f32_16x16x32_bf16(Bt[n][k], At[m][k], acc[ai][bj][m][n], 0, 0, 0); __builtin_amdgcn_s_setprio(0); } while (0)
#define PG8_WAIT_V(n) asm volatile("s_waitcnt vmcnt(" #n ")" ::: "memory")
#define PG8_WAIT_L(n) asm volatile("s_waitcnt lgkmcnt(" #n ")" ::: "memory")
#define PG8_BAR __builtin_amdgcn_s_barrier()
#define PG8_SCHED __builtin_amdgcn_sched_barrier(0)
    Unit cur, nxt; int ui = 0;
    if (!unit_at(g, 0, G, c, cur)) return;
    f32x4 acc[2][2][4][2];
#pragma unroll
    for (int a = 0; a < 2; ++a)
#pragma unroll
        for (int b = 0; b < 2; ++b)
#pragma unroll
            for (int m = 0; m < 4; ++m)
#pragma unroll
                for (int n = 0; n < 2; ++n) acc[a][b][m][n] = (f32x4){0.f, 0.f, 0.f, 0.f};
    bf16x8 At[4][2], B0[2][2], B1[2][2];
    const char* cA = (const char*)g.A + (size_t)cur.pm * tstepA + (size_t)cur.pn * pnA; const char* cB = (const char*)g.Bt + (size_t)cur.pn * tstepB;
    PG8_STAGE(PG8_SB(0, 0), cB, voffB); PG8_STAGE(PG8_SB(0, 1), cB + hstepB, voffB); PG8_STAGE(PG8_SA(0, 0), cA, voffA); PG8_STAGE(PG8_SA(0, 1), cA + hstepA, voffA);
    if (wr == 1) PG8_BAR;
    PG8_WAIT_V(2); PG8_BAR;
    PG8_STAGE(PG8_SB(1, 0), cB + kstep, voffB); PG8_STAGE(PG8_SA(1, 0), cA + kstep, voffA); PG8_STAGE(PG8_SB(1, 1), cB + hstepB + kstep, voffB);
    PG8_WAIT_V(6); PG8_BAR;
    for (;;) {
        const bool has_next = unit_at(g, ui + 1, G, c, nxt);
        const char* nA = has_next ? (const char*)g.A + (size_t)nxt.pm * tstepA + (size_t)nxt.pn * pnA : cA; const char* nB = has_next ? (const char*)g.Bt + (size_t)nxt.pn * tstepB : cB;
        for (int t = 0; t < nt; t += 2) {
            const bool last = (t == nt - 2);
            const char* a1 = cA + (size_t)(t + 1) * kstep;
            const char* a2 = last ? nA : cA + (size_t)(t + 2) * kstep; const char* b2 = last ? nB : cB + (size_t)(t + 2) * kstep;
            const char* a3 = a2 + kstep; const char* b3 = b2 + kstep;
            PG8_LDB(B0, 0, 0); PG8_LDB(B1, 0, 1); PG8_SCHED; PG8_LDA(At, 0, 0); PG8_STAGE(PG8_SA(1, 1), a1 + hstepA, voffA);
            PG8_WAIT_V(8); PG8_WAIT_L(0); PG8_BAR; PG8_MMA(0, 0, At, B0); PG8_MMA(0, 1, At, B1); PG8_BAR; PG8_SCHED;
            PG8_LDA(At, 0, 1); PG8_STAGE(PG8_SB(0, 0), b2, voffB); PG8_STAGE(PG8_SB(0, 1), b2 + hstepB, voffB); PG8_STAGE(PG8_SA(0, 0), a2, voffA);
            PG8_WAIT_V(8); PG8_WAIT_L(0); PG8_BAR; PG8_MMA(1, 0, At, B0); PG8_MMA(1, 1, At, B1); PG8_BAR; PG8_SCHED;
            PG8_LDB(B0, 1, 0); PG8_LDB(B1, 1, 1); PG8_SCHED; PG8_LDA(At, 1, 0); PG8_STAGE(PG8_SA(0, 1), a2 + hstepA, voffA);
            PG8_WAIT_V(8); PG8_WAIT_L(0); PG8_BAR; PG8_MMA(0, 0, At, B0); PG8_MMA(0, 1, At, B1); PG8_BAR; PG8_SCHED;
            PG8_LDA(At, 1, 1); PG8_STAGE(PG8_SB(1, 0), b3, voffB); PG8_STAGE(PG8_SB(1, 1), b3 + hstepB, voffB); PG8_STAGE(PG8_SA(1, 0), a3, voffA);
            PG8_WAIT_V(8); PG8_WAIT_L(0); PG8_BAR; PG8_MMA(1, 0, At, B0); PG8_MMA(1, 1, At, B1); PG8_BAR; PG8_SCHED;
        }
        if (wr == 0) PG8_BAR;
        epilogue(kind, l, acc, cur, wr, wc, fr, fq);
        __builtin_amdgcn_s_waitcnt(0x0F70);
        if (!has_next) break;
#pragma unroll
        for (int a = 0; a < 2; ++a)
#pragma unroll
            for (int b = 0; b < 2; ++b)
#pragma unroll
                for (int m = 0; m < 4; ++m)
#pragma unroll
                    for (int n = 0; n < 2; ++n) acc[a][b][m][n] = (f32x4){0.f, 0.f, 0.f, 0.f};
        cur = nxt; cA = nA; cB = nB; ++ui;
        if (wr == 1) PG8_BAR;
    }
    PG8_WAIT_V(0);
    PG8_BAR;
#undef PG8_SA
#undef PG8_SB
#undef PG8_STAGE
#undef PG8_LDA
#undef PG8_LDB
#undef PG8_MMA
#undef PG8_WAIT_V
#undef PG8_WAIT_L
#undef PG8_BAR
#undef PG8_SCHED
}

DI void mini_gemm(LAS unsigned char* lds, const GemmD g, const int kind, const int l) {
    const int tid = tid_(), wid = __builtin_amdgcn_readfirstlane(tid >> 6), lane = tid & 63, fr = lane & 15, fq = lane >> 4;
    LAS float* part = (LAS float*)lds;
    const int kw = g.K >> 3;
    for (int mu = bid_(); mu < 256; mu += gdim_()) {
        const int m0 = TP + (mu >> 4) * 32, n0 = (mu & 15) * 64;
        const bf16_t* Ab = g.A + (size_t)m0 * g.lda + (size_t)(n0 >> 8) * g.a_pn_off + wid * kw + 8 * fq;
        const bf16_t* Bb = g.Bt + (size_t)n0 * g.ldb + wid * kw + 8 * fq;
        f32x4 acc[2][4];
#pragma unroll
        for (int mb = 0; mb < 2; ++mb)
#pragma unroll
            for (int nb = 0; nb < 4; ++nb) acc[mb][nb] = (f32x4){0.f, 0.f, 0.f, 0.f};
#pragma unroll 4
        for (int k = 0; k < kw; k += 32) { bf16x8 a[2], b[4];
#pragma unroll
            for (int mb = 0; mb < 2; ++mb) a[mb] = *(const bf16x8*)(Ab + (size_t)(16 * mb + fr) * g.lda + k);
#pragma unroll
            for (int nb = 0; nb < 4; ++nb) b[nb] = *(const bf16x8*)(Bb + (size_t)(16 * nb + fr) * g.ldb + k);
#pragma unroll
            for (int mb = 0; mb < 2; ++mb)
#pragma unroll
                for (int nb = 0; nb < 4; ++nb) acc[mb][nb] = MFMA16(b[nb], a[mb], acc[mb][nb]); }
#pragma unroll
        for (int mb = 0; mb < 2; ++mb)
#pragma unroll
            for (int nb = 0; nb < 4; ++nb) *(LAS f32x4*)(part + (wid * 32 + 16 * mb + fr) * 68 + 16 * nb + 4 * fq) = acc[mb][nb];
        LDS_BARRIER();
        { const int r = tid >> 4, c4 = (tid & 15) * 4; f32x4 v = {0.f, 0.f, 0.f, 0.f};
#pragma unroll
          for (int w = 0; w < 8; ++w) v += *(const LAS f32x4*)(part + (w * 32 + r) * 68 + c4);
          const EpiD E = make_epi(kind, l, true); const int row = m0 + r, col = n0 + c4;
          if (E.mode == EM_PLAIN) { u32x2 w; w.x = pk2(v[0], v[1]); w.y = pk2(v[2], v[3]); *(u32x2*)(E.o0 + (size_t)row * DM + col) = w; }
          else { float* xp = E.x + (size_t)row * DM + col; f32x4 x0 = *(const f32x4*)(E.xin + (size_t)row * DM + col);
              if (E.mode == EM_PLE) { const float rs = rs_of(sum16(E.ss_in + (size_t)row * 16), 1.f / 1024.f); const u32x2 pw = *(const u32x2*)(E.ppb + (size_t)row * DM + col);
                  x0[0] += sigmoidf_(v[0] * rs) * bflo(pw.x) * E.alpha; x0[1] += sigmoidf_(v[1] * rs) * bfhi(pw.x) * E.alpha; x0[2] += sigmoidf_(v[2] * rs) * bflo(pw.y) * E.alpha; x0[3] += sigmoidf_(v[3] * rs) * bfhi(pw.y) * E.alpha; }
              else if (E.cs) x0 += v * *(const f32x4*)(E.cs + col) * E.alpha;
              else x0 += v * E.alpha;
              *(f32x4*)xp = x0; u32x2 w; w.x = pk2(x0[0], x0[1]); w.y = pk2(x0[2], x0[3]); *(u32x2*)(E.xb + (size_t)row * DM + col) = w;
              float sq = (x0[0] * x0[0] + x0[1] * x0[1]) + (x0[2] * x0[2] + x0[3] * x0[3]);
              sq += __shfl_xor(sq, 1); sq += __shfl_xor(sq, 2); sq += __shfl_xor(sq, 4); sq += __shfl_xor(sq, 8);
              if ((tid & 15) == 0) E.ss_out[(size_t)row * 16 + (n0 >> 6)] = sq; } }
        LDS_BARRIER();
    }
}

struct Job { const float* src; const float* scale; bf16_t* dst; int K, N, ldk, mode; };
constexpr int NJOBS = 42;
DI Job get_job(const Params& P, int j) {
    Job b; b.scale = nullptr; b.mode = 0;
    unsigned char* ws = P.ws;
    if (j < 32) { const int l = j >> 3, s = j & 7;
        if (s == 0 || s == 1 || s == 3 || s == 4) { const bool second = s >= 3; const bool up = (s == 1 || s == 4);
            b.src = P.in[second ? (up ? I_F2U : I_F2G) : (up ? I_F1U : I_F1G)] + (size_t)l * 1024 * FF; b.scale = P.in[second ? I_NF2 : I_NF1] + l * 1024;
            b.dst = (bf16_t*)(ws + (second ? O_W2 : O_W1) + (size_t)l * SZ_W1); b.K = 1024; b.N = FF; b.ldk = 1024; b.mode = up ? 2 : 1;
        } else if (s == 2 || s == 5) { const bool second = s == 5;
            b.src = P.in[second ? I_F2D : I_F1D] + (size_t)l * FF * 1024; b.dst = (bf16_t*)(ws + (second ? O_D2 : O_D1) + (size_t)l * SZ_D1); b.K = FF; b.N = 1024; b.ldk = FF;
        } else if (s == 6) { b.src = P.in[I_PLEG] + (size_t)l * 1024 * 1024; b.scale = P.in[I_NPLE] + l * 1024; b.dst = (bf16_t*)(ws + O_PG + (size_t)l * SZ_SQ); b.K = 1024; b.N = 1024; b.ldk = 1024;
        } else { b.src = P.in[I_PLEP] + (size_t)l * 256 * 1024; b.dst = (bf16_t*)(ws + O_PPW + (size_t)l * SZ_PPW); b.K = 256; b.N = 1024; b.ldk = 256; }
    } else if (j == 32) { b.src = P.in[I_GMIN]; b.scale = P.in[I_NMIX]; b.dst = (bf16_t*)(ws + O_GMIN); b.K = 1024; b.N = 2048; b.ldk = 1024;
    } else if (j == 33) { b.src = P.in[I_GMOUT]; b.dst = (bf16_t*)(ws + O_GMOUT); b.K = 1024; b.N = 1024; b.ldk = 1024;
    } else if (j < 38) { const int gi = j - 34; b.src = P.in[I_POOLW] + (size_t)gi * 65536; b.dst = (bf16_t*)(ws + O_POOLW) + (size_t)gi * 65536; b.K = 256; b.N = 256; b.ldk = 256;
    } else if (j == 38) { b.src = P.in[I_GLAIN]; b.scale = P.in[I_NMIX] + 2048; b.dst = (bf16_t*)(ws + O_GLAIN); b.K = 1024; b.N = 3072; b.ldk = 1024;
    } else if (j == 39) { b.src = P.in[I_GLAOUT]; b.dst = (bf16_t*)(ws + O_GLAOUT); b.K = 1024; b.N = 1024; b.ldk = 1024;
    } else if (j == 40) { b.src = P.in[I_SSMIN]; b.scale = P.in[I_NMIX] + 3072; b.dst = (bf16_t*)(ws + O_SSMIN); b.K = 1024; b.N = 5152; b.ldk = 1024;
    } else { b.src = P.in[I_SSMOUT]; b.scale = P.in[I_SSMNORM]; b.dst = (bf16_t*)(ws + O_SSMOUT); b.K = 2048; b.N = 1024; b.ldk = 2048; }
    return b;
}
DI void transpose_item(const Job& jb, int item, LAS float* scr, int lane) {
    const int nblk = (jb.N + 63) >> 6, kb = item / nblk, nb = item - kb * nblk, k0 = 32 * kb, n0 = 64 * nb;
    const int nl = (lane & 15) * 4, kr = lane >> 4;
    const bool ok = (n0 + nl) < jb.N;
    f32x4 v[8];
#pragma unroll
    for (int i = 0; i < 8; ++i) v[i] = ok ? __builtin_nontemporal_load((const f32x4*)(jb.src + (size_t)(k0 + 4 * i + kr) * jb.N + n0 + nl)) : (f32x4){0.f, 0.f, 0.f, 0.f};
#pragma unroll
    for (int i = 0; i < 8; ++i) { const int kk = 4 * i + kr; const float sc = jb.scale ? jb.scale[k0 + kk] : 1.f; LAS float* d = scr + kk * 65 + nl;
        d[0] = v[i][0] * sc; d[1] = v[i][1] * sc; d[2] = v[i][2] * sc; d[3] = v[i][3] * sc; }
    asm volatile("s_waitcnt lgkmcnt(0)" ::: "memory");
    const int c = lane & 3;
#pragma unroll
    for (int j = 0; j < 4; ++j) { const int n = (lane >> 2) + 16 * j; const LAS float* s = scr + (8 * c) * 65 + n;
        u32x4 o; o.x = pk2(s[0 * 65], s[1 * 65]); o.y = pk2(s[2 * 65], s[3 * 65]); o.z = pk2(s[4 * 65], s[5 * 65]); o.w = pk2(s[6 * 65], s[7 * 65]);
        const int nn = n0 + n;
        if (nn < jb.N) { const int drow = jb.mode == 0 ? nn : ((nn >> 2) * 8 + (nn & 3) + (jb.mode == 2 ? 4 : 0)); *(u32x4*)(jb.dst + (size_t)drow * jb.ldk + k0 + 8 * c) = o; } }
    asm volatile("s_waitcnt lgkmcnt(0)" ::: "memory");
}

DI void phase0(const Params& P, LAS unsigned char* lds) {
    const int tid = tid_(), wid = tid >> 6, lane = tid & 63;
    const int gw = bid_() * 8 + wid, NW = gdim_() * 8;
    const int gt = bid_() * 512 + tid, NT = gdim_() * 512;
    unsigned char* ws = P.ws;
    { float* X = (float*)(ws + O_X); bf16_t* XB = (bf16_t*)(ws + O_XB); float* ST = (float*)(ws + O_ST);
      for (int row = gw; row < T; row += NW) {
          const float* src = row < TP ? P.in[I_XP] + (size_t)row * DM : P.in[I_XS] + (size_t)(row - TP) * DM;
          float sq = 0.f;
#pragma unroll
          for (int j = 0; j < 4; ++j) { const f32x4 v = *(const f32x4*)(src + lane * 4 + 256 * j);
              u32x2 w; w.x = pk2(v[0], v[1]); w.y = pk2(v[2], v[3]); *(u32x2*)(XB + (size_t)row * DM + lane * 4 + 256 * j) = w;
              sq += (v[0] * v[0] + v[1] * v[1]) + (v[2] * v[2] + v[3] * v[3]); }
#pragma unroll
          for (int o = 32; o >= 1; o >>= 1) sq += __shfl_xor(sq, o);
          if (lane < 16) ST[(size_t)row * 16 + lane] = lane == 0 ? sq : 0.f; } }
    { bf16_t* GI = (bf16_t*)(ws + O_GLAIN); const float* a1 = P.in[I_GLAA1]; const float* g = P.in[I_NMIX] + 2048;
      for (int i = gt; i < 16 * 1024; i += NT) { const int n = i >> 10, k = i & 1023; GI[(size_t)(3072 + n) * 1024 + k] = f2bf(a1[k * 16 + n] * g[k]); }
      bf16_t* WS = (bf16_t*)(ws + O_WSB); const float* w = P.in[I_GMWS];
      for (int i = gt; i < 8 * 128 * 128; i += NT) { const int t = (i >> 7) & 127, s = i & 127; WS[i] = f2bf(s <= t ? w[i] : 0.f); } }
    { LAS float* scr = (LAS float*)lds + wid * (32 * 65);
      int start = gw;
      for (int j = 0; j < NJOBS; ++j) { const Job jb = get_job(P, j); const int n = (jb.K / 32) * ((jb.N + 63) >> 6);
          for (int it = start; it < n; it += NW) transpose_item(jb, it, scr, lane);
          start = (((start - n) % NW) + NW) % NW; } }
}

DI void conv_p(const Params& P, int l) {
    const int gt = bid_() * 512 + tid_(), NT = gdim_() * 512; bf16_t* PB = (bf16_t*)(P.ws + O_PBF);
#pragma unroll 4
    for (int i = gt; i < T * 64; i += NT) { const int row = i >> 6, c4 = (i & 63) * 4;
        const float* src = row < TP ? P.in[I_PP] + ((size_t)l * TP + row) * 256 + c4 : P.in[I_PS] + ((size_t)l * 512 + (row - TP)) * 256 + c4;
        const f32x4 v = *(const f32x4*)src; u32x2 w; w.x = pk2(v[0], v[1]); w.y = pk2(v[2], v[3]); *(u32x2*)(PB + (size_t)row * 256 + c4) = w; }
}

DI void gm_spatial(const Params& P, LAS unsigned char* lds) {
    const int tid = tid_(), wid = __builtin_amdgcn_readfirstlane(tid >> 6), lane = tid & 63, fr = lane & 15, fq = lane >> 4;
    unsigned char* ws = P.ws;
    const bf16_t* U = (const bf16_t*)(ws + O_R + R_U); const bf16_t* V = (const bf16_t*)(ws + O_R + R_V); bf16_t* GU = (bf16_t*)(ws + O_R + R_GU);
    const float* GS = (const float*)(ws + O_ST) + ST_GSP; const bf16_t* WSB = (const bf16_t*)(ws + O_WSB);
    const float* lng = P.in[I_GMLN]; const float* bs = P.in[I_GMBS];
    LAS bf16_t* Vt = (LAS bf16_t*)lds;
    for (int u = bid_(); u < 1024; u += gdim_()) {
        const int g = u & 7, row0 = (u >> 3) * 128;
        { const int s = tid & 127; const int row = row0 + s; float s1 = 0.f, s2 = 0.f;
#pragma unroll
          for (int q = 0; q < 8; ++q) { const f32x4 gq = *(const f32x4*)(GS + (size_t)row * 32 + 4 * q); s1 += gq[0] + gq[2]; s2 += gq[1] + gq[3]; }
          const float mean = s1 * (1.f / 1024.f); const float var = s2 * (1.f / 1024.f) - mean * mean; const float rstd = rsqrtf(var + EPS);
#pragma unroll
          for (int i = 0; i < 4; ++i) { const int c8 = ((tid >> 7) + 4 * i) * 8; const u32x4 w = *(const u32x4*)(V + (size_t)row * DM + g * 128 + c8); float f[8]; unpack8(w, f);
#pragma unroll
              for (int j = 0; j < 8; ++j) Vt[(c8 + j) * 136 + s] = f2bf((f[j] - mean) * rstd * lng[g * 128 + c8 + j]); } }
        LDS_BARRIER();
        f32x4 acc[8];
#pragma unroll
        for (int nb = 0; nb < 8; ++nb) acc[nb] = (f32x4){0.f, 0.f, 0.f, 0.f};
        const int nks = (wid >> 1) + 1;
        for (int ks = 0; ks < nks; ++ks) {
            const bf16x8 a = *(const bf16x8*)(WSB + (size_t)(g * 128 + 16 * wid + fr) * 128 + 32 * ks + 8 * fq);
#pragma unroll
            for (int nb = 0; nb < 8; ++nb) { const bf16x8 b = *(const LAS bf16x8*)(Vt + (16 * nb + fr) * 136 + 32 * ks + 8 * fq); acc[nb] = MFMA16(b, a, acc[nb]); } }
        { const int tl = 16 * wid + fr; const float bias = bs[g * 128 + tl]; const size_t rb = (size_t)(row0 + tl) * DM + g * 128 + 4 * fq;
#pragma unroll
          for (int nb = 0; nb < 8; ++nb) { const u32x2 uw = *(const u32x2*)(U + rb + 16 * nb); u32x2 w;
              w.x = pk2(bflo(uw.x) * (acc[nb][0] + bias), bfhi(uw.x) * (acc[nb][1] + bias)); w.y = pk2(bflo(uw.y) * (acc[nb][2] + bias), bfhi(uw.y) * (acc[nb][3] + bias));
              *(u32x2*)(GU + rb + 16 * nb) = w; } }
        LDS_BARRIER();
    }
    { const int gt = bid_() * 512 + tid, NT = gdim_() * 512; const float* wsf = P.in[I_GMWS]; float* CV = P.out + OUT_CV;
      for (int e = gt; e < 128 * 1024; e += NT) { const int b = e >> 10, c = e & 1023, g = c >> 7; float vl[4];
#pragma unroll
          for (int s = 0; s < 4; ++s) { const int row = TP + 4 * b + s; float s1 = 0.f, s2 = 0.f;
#pragma unroll
              for (int q = 0; q < 8; ++q) { const f32x4 gq = *(const f32x4*)(GS + (size_t)row * 32 + 4 * q); s1 += gq[0] + gq[2]; s2 += gq[1] + gq[3]; }
              const float mean = s1 * (1.f / 1024.f); const float var = s2 * (1.f / 1024.f) - mean * mean;
              vl[s] = (bf2f(V[(size_t)row * DM + c]) - mean) * rsqrtf(var + EPS) * lng[c]; CV[(size_t)(4 * b + s) * DM + c] = vl[s]; }
#pragma unroll
          for (int t = 0; t < 4; ++t) { float sv = bs[g * 128 + t];
#pragma unroll
              for (int s = 0; s <= t; ++s) sv += wsf[(g * 128 + t) * 128 + s] * vl[s];
              const size_t o = (size_t)(TP + 4 * b + t) * DM + c; GU[o] = f2bf(bf2f(U[o]) * sv); } } }
}

DI void pool_prep(const Params& P, LAS unsigned char* lds) {
    const int tid = tid_(); unsigned char* ws = P.ws;
    const float* X = (const float*)(ws + O_X); const float* SS = (const float*)(ws + O_ST) + (size_t)16 * T; bf16_t* DF = (bf16_t*)(ws + O_R + R_DIFF);
    const float* gm = P.in[I_NMIX] + 1024; const float* hist = P.in[I_SPOOL];
    const int sub = tid >> 8, c4 = (tid & 255) * 4, w = 2 << (c4 >> 8);
    const f32x4 g4 = *(const f32x4*)(gm + c4);
    LAS float* rsl = (LAS float*)lds + sub * 32;
    for (int it = bid_() * 2 + sub; it < 1152; it += gdim_() * 2) {
        LDS_BARRIER();
        if (it < 1024) { const int b = it >> 7, t0 = (it & 127) * 16; const size_t rb = (size_t)b * 2048; const int k = tid & 255;
            if (k < 31) { const int tt = t0 - 15 + k; rsl[k] = tt >= 0 ? rs_of(sum16(SS + (rb + tt) * 16), 1.f / 1024.f) : 0.f; } }
        LDS_BARRIER();
        if (it < 1024) { const int b = it >> 7, t0 = (it & 127) * 16; const size_t rb = (size_t)b * 2048;
            f32x4 sum = {0.f, 0.f, 0.f, 0.f};
            for (int j = 1; j < w; ++j) { const int tt = t0 - j; if (tt >= 0) { const float rs = rsl[15 - j]; sum += *(const f32x4*)(X + (rb + tt) * DM + c4) * g4 * rs; } }
#pragma unroll 8
            for (int t = t0; t < t0 + 16; ++t) { const float rs = rsl[t - t0 + 15]; const f32x4 cur = *(const f32x4*)(X + (rb + t) * DM + c4) * g4 * rs;
                sum += cur; const float ic = __builtin_amdgcn_rcpf((float)(t + 1 < w ? t + 1 : w)); const f32x4 d = sum * ic - cur;
                u32x2 o; o.x = pk2(d[0], d[1]); o.y = pk2(d[2], d[3]); *(u32x2*)(DF + (rb + t) * DM + c4) = o;
                if (t >= 2033) *(f32x4*)(P.out + OUT_POOLP + ((size_t)b * 15 + (t - 2033)) * DM + c4) = cur;
                const int tt = t - w + 1; if (tt >= 0) { const float r2 = rsl[tt - t0 + 15]; sum -= *(const f32x4*)(X + (rb + tt) * DM + c4) * g4 * r2; } }
        } else { const int b = it - 1024; const size_t rb = (size_t)TP + 4 * b; const float* hb = hist + (size_t)b * 15 * DM + c4;
            f32x4 sum = {0.f, 0.f, 0.f, 0.f}; f32x4 hc[4];
            for (int j = 1; j < w; ++j) sum += *(const f32x4*)(hb + (size_t)(15 - j) * DM);
            const float ic = 1.f / (float)w;
#pragma unroll
            for (int t = 0; t < 4; ++t) { const float rs = rs_of(sum16(SS + (rb + t) * 16), 1.f / 1024.f); const f32x4 cur = *(const f32x4*)(X + (rb + t) * DM + c4) * g4 * rs; hc[t] = cur;
                sum += cur; const f32x4 d = sum * ic - cur; u32x2 o; o.x = pk2(d[0], d[1]); o.y = pk2(d[2], d[3]); *(u32x2*)(DF + (rb + t) * DM + c4) = o;
                const int tt = t - w + 1; f32x4 old;
                if (tt >= 0) old = (tt == 0 ? hc[0] : (tt == 1 ? hc[1] : hc[2])); else old = *(const f32x4*)(hb + (size_t)(15 + tt) * DM);
                sum -= old; }
            float* po = P.out + OUT_POOLS + (size_t)b * 15 * DM + c4;
            for (int j = 0; j < 11; ++j) *(f32x4*)(po + (size_t)j * DM) = *(const f32x4*)(hb + (size_t)(4 + j) * DM);
#pragma unroll
            for (int j = 0; j < 4; ++j) *(f32x4*)(po + (size_t)(11 + j) * DM) = hc[j];
        }
    }
}

DI void gla_prep(const Params& P, LAS unsigned char* lds) {
    const int ch = tid_(); unsigned char* ws = P.ws;
    const bf16_t* QK = (const bf16_t*)(ws + O_R + R_QKVR); const float* T16 = (const float*)(ws + O_R + R_T16);
    bf16_t* QD = (bf16_t*)(ws + O_R + R_QD); bf16_t* KI = (bf16_t*)(ws + O_R + R_KI); float* DEC = (float*)(ws + O_R + R_DEC); float* SA = (float*)(ws + O_R + R_SA);
    float w2[16];
#pragma unroll
    for (int r = 0; r < 16; ++r) w2[r] = P.in[I_GLAA2][r * 512 + ch];
    const float ba = P.in[I_GLABA][ch];
    for (int it = bid_(); it < 384; it += gdim_()) {
        const bool prompt = it < 256; const int row0 = prompt ? it * 64 : TP + (it - 256) * 4; const int nt = prompt ? 64 : 4;
        float b = 0.f;
        LAS float* t16s = (LAS float*)lds;
        LDS_BARRIER();
        for (int i = ch; i < nt * 4; i += 512) *(LAS f32x4*)(t16s + 4 * i) = *(const f32x4*)(T16 + (size_t)row0 * 16 + 4 * i);
        LDS_BARRIER();
#pragma unroll 4
        for (int t = 0; t < nt; ++t) { const int row = row0 + t; float z = ba;
#pragma unroll
            for (int r4 = 0; r4 < 4; ++r4) { const f32x4 tv = *(const LAS f32x4*)(t16s + t * 16 + 4 * r4); z += tv[0] * w2[4 * r4] + tv[1] * w2[4 * r4 + 1] + tv[2] * w2[4 * r4 + 2] + tv[3] * w2[4 * r4 + 3]; }
            const float la = (fminf(z, 0.f) - __logf(1.0f + __expf(-fabsf(z)))) * (1.f / 16.f);
            if (prompt) { b += la; const float q = bf2f(QK[(size_t)row * 3072 + ch]), k = bf2f(QK[(size_t)row * 3072 + 512 + ch]);
                QD[(size_t)row * 512 + ch] = f2bf(q * __expf(b)); KI[(size_t)row * 512 + ch] = f2bf(k * __expf(-b)); }
            else SA[(size_t)(row - TP) * 512 + ch] = __expf(la); }
        if (prompt) DEC[(size_t)it * 512 + ch] = __expf(b);
    }
}

DI void gla_scan(const Params& P, LAS unsigned char* lds) {
    const int tid = tid_(), wid = __builtin_amdgcn_readfirstlane(tid >> 6), lane = tid & 63, fr = lane & 15, fq = lane >> 4;
    unsigned char* ws = P.ws;
    const bf16_t* QK = (const bf16_t*)(ws + O_R + R_QKVR); const bf16_t* QD = (const bf16_t*)(ws + O_R + R_QD); const bf16_t* KI = (const bf16_t*)(ws + O_R + R_KI);
    const float* DEC = (const float*)(ws + O_R + R_DEC); const float* SA = (const float*)(ws + O_R + R_SA); bf16_t* OB = (bf16_t*)(ws + O_R + R_OBUF);
    float* GSS = (float*)(ws + O_ST) + ST_GSSP;
    constexpr int GSET = 9216 + 4608 + 8704 + 18432;
    LAS bf16_t* St0 = (LAS bf16_t*)(lds + 9216 + 4608);
    const int mb = wid >> 1, vb = wid & 1;
    for (int it = bid_(); it < 256; it += gdim_()) {
        const int vs = it & 7, h = (it >> 3) & 3, b = it >> 5;
        f32x4 Sacc[2] = {{0.f, 0.f, 0.f, 0.f}, {0.f, 0.f, 0.f, 0.f}};
        for (int i = tid; i < 32 * 136 / 2; i += 512) ((LAS unsigned*)St0)[i] = 0u;
        u32x4 vw = {0u, 0u, 0u, 0u}, kw[2]; bf16x8 qa[4], kbf[2][4]; f32x4 dc;
#define GLA_LOAD(ROW0, NCH, QA, DC) do { \
            if (tid < 256) vw = *(const u32x4*)(QK + (size_t)((ROW0) + (tid & 63)) * 3072 + 1024 + h * 256 + vs * 32 + (tid >> 6) * 8); \
            _Pragma("unroll") for (int i_ = 0; i_ < 2; ++i_) { const int idx_ = tid + 512 * i_; kw[i_] = *(const u32x4*)(KI + (size_t)((ROW0) + (idx_ & 63)) * 512 + h * 128 + (idx_ >> 6) * 8); } \
            _Pragma("unroll") for (int ks_ = 0; ks_ < 4; ++ks_) QA[ks_] = *(const bf16x8*)(QD + (size_t)((ROW0) + 16 * mb + fr) * 512 + h * 128 + 32 * ks_ + 8 * fq); \
            _Pragma("unroll") for (int i_ = 0; i_ < 2; ++i_) _Pragma("unroll") for (int ks_ = 0; ks_ < 4; ++ks_) kbf[i_][ks_] = *(const bf16x8*)(KI + (size_t)((ROW0) + 16 * (2 * vb + i_) + fr) * 512 + h * 128 + 32 * ks_ + 8 * fq); \
            DC = *(const f32x4*)(DEC + (size_t)(NCH) * 512 + h * 128 + 16 * wid + 4 * fq); } while (0)
        GLA_LOAD(b * 2048, b * 32, qa, dc);
        for (int n = 0; n < 32; ++n) {
            const int row0 = b * 2048 + 64 * n;
            LAS unsigned char* sb_ = lds + (n & 1) * GSET; LAS unsigned char* so_ = lds + ((n & 1) ^ 1) * GSET;
            LAS bf16_t* Pm = (LAS bf16_t*)sb_; LAS bf16_t* Vt = (LAS bf16_t*)(sb_ + 9216); LAS bf16_t* St = (LAS bf16_t*)(sb_ + 13824); LAS bf16_t* KIt = (LAS bf16_t*)(sb_ + 22528);
            LAS bf16_t* Stn = (LAS bf16_t*)(so_ + 13824);
            if (tid < 256) { const int s = tid & 63, v8 = (tid >> 6) * 8; const bf16_t* e = (const bf16_t*)&vw;
#pragma unroll
                for (int j = 0; j < 8; ++j) Vt[(v8 + j) * 72 + s] = e[j]; }
#pragma unroll
            for (int i = 0; i < 2; ++i) { const int idx = tid + 512 * i, s = idx & 63, d8 = (idx >> 6) * 8; const bf16_t* e = (const bf16_t*)&kw[i];
#pragma unroll
                for (int j = 0; j < 8; ++j) KIt[(d8 + j) * 72 + s] = e[j]; }
#pragma unroll
            for (int i = 0; i < 2; ++i) { const int nb = 2 * vb + i; f32x4 sc = {0.f, 0.f, 0.f, 0.f};
#pragma unroll
                for (int ks = 0; ks < 4; ++ks) sc = MFMA16(qa[ks], kbf[i][ks], sc);
#pragma unroll
                for (int j = 0; j < 4; ++j) { const int t = 16 * mb + 4 * fq + j, s = 16 * nb + fr; Pm[t * 72 + s] = f2bf(s <= t ? sc[j] : 0.f); } }
            LDS_BARRIER();
            bf16x8 qn[4]; f32x4 dn = dc;
#pragma unroll
            for (int ks = 0; ks < 4; ++ks) qn[ks] = qa[ks];
            if (n + 1 < 32) GLA_LOAD(row0 + 64, b * 32 + n + 1, qn, dn);
            f32x4 o = {0.f, 0.f, 0.f, 0.f};
#pragma unroll
            for (int k2 = 0; k2 < 2; ++k2) { const bf16x8 a = *(const LAS bf16x8*)(Pm + (16 * mb + fr) * 72 + 32 * k2 + 8 * fq); const bf16x8 bb = *(const LAS bf16x8*)(Vt + (16 * vb + fr) * 72 + 32 * k2 + 8 * fq); o = MFMA16(a, bb, o); }
#pragma unroll
            for (int ks = 0; ks < 4; ++ks) { const bf16x8 bb = *(const LAS bf16x8*)(St + (16 * vb + fr) * 136 + 32 * ks + 8 * fq); o = MFMA16(qa[ks], bb, o); }
#pragma unroll
            for (int j = 0; j < 4; ++j) { const int row = row0 + 16 * mb + 4 * fq + j; OB[(size_t)row * DM + h * 256 + vs * 32 + 16 * vb + fr] = f2bf(o[j]); }
#pragma unroll
            for (int k2 = 0; k2 < 2; ++k2) { const bf16x8 a = *(const LAS bf16x8*)(KIt + (16 * wid + fr) * 72 + 32 * k2 + 8 * fq);
#pragma unroll
                for (int v2 = 0; v2 < 2; ++v2) { const bf16x8 bb = *(const LAS bf16x8*)(Vt + (16 * v2 + fr) * 72 + 32 * k2 + 8 * fq); Sacc[v2] = MFMA16(a, bb, Sacc[v2]); } }
            Sacc[0] *= dc; Sacc[1] *= dc;
#pragma unroll
            for (int v2 = 0; v2 < 2; ++v2) { u32x2 w; w.x = pk2(Sacc[v2][0], Sacc[v2][1]); w.y = pk2(Sacc[v2][2], Sacc[v2][3]); *(LAS u32x2*)(Stn + (16 * v2 + fr) * 136 + 16 * wid + 4 * fq) = w; }
#pragma unroll
            for (int ks = 0; ks < 4; ++ks) qa[ks] = qn[ks];
            dc = dn;
        }
#undef GLA_LOAD
        float* GO = P.out + OUT_GLAP + ((size_t)(b * 4 + h) * 128) * 256 + vs * 32;
#pragma unroll
        for (int v2 = 0; v2 < 2; ++v2)
#pragma unroll
            for (int j = 0; j < 4; ++j) GO[(size_t)(16 * wid + 4 * fq + j) * 256 + 16 * v2 + fr] = Sacc[v2][j];
        LDS_BARRIER();
    }
    LAS float* red = (LAS float*)lds;
    for (int it = bid_(); it < 512; it += gdim_()) {
        const int b = it >> 2, h = it & 3; const int v4 = lane * 4;
        const float* S0 = P.in[I_SGLA] + ((size_t)(b * 4 + h) * 128 + 16 * wid) * 256 + v4;
        f32x4 S[16];
#pragma unroll
        for (int i = 0; i < 16; ++i) S[i] = __builtin_nontemporal_load((const f32x4*)(S0 + (size_t)i * 256));
#pragma unroll
        for (int t = 0; t < 4; ++t) { const int row = TP + 4 * b + t; const bf16_t* qk = QK + (size_t)row * 3072;
            const u32x2 vw = *(const u32x2*)(qk + 1024 + h * 256 + v4); const f32x4 v = {bflo(vw.x), bfhi(vw.x), bflo(vw.y), bfhi(vw.y)};
            f32x4 po = {0.f, 0.f, 0.f, 0.f};
            const int dl = h * 128 + 16 * wid + (lane & 15);
            const float a_l = SA[(size_t)(4 * b + t) * 512 + dl]; const float q_l = bf2f(qk[dl]), k_l = bf2f(qk[512 + dl]);
#pragma unroll
            for (int i = 0; i < 16; ++i) { const float a = __builtin_bit_cast(float, __builtin_amdgcn_readlane(__builtin_bit_cast(int, a_l), i));
                const float q = __builtin_bit_cast(float, __builtin_amdgcn_readlane(__builtin_bit_cast(int, q_l), i)), k = __builtin_bit_cast(float, __builtin_amdgcn_readlane(__builtin_bit_cast(int, k_l), i));
                S[i] = S[i] * a + v * k; po += S[i] * q; }
            *(LAS f32x4*)(red + (t * 8 + wid) * 256 + v4) = po; }
        float* SO = P.out + OUT_GLAS + ((size_t)(b * 4 + h) * 128 + 16 * wid) * 256 + v4;
#pragma unroll
        for (int i = 0; i < 16; ++i) __builtin_nontemporal_store(S[i], (f32x4*)(SO + (size_t)i * 256));
        LDS_BARRIER();
#pragma unroll
        for (int i = 0; i < 2; ++i) { const int idx = tid + 512 * i, t = idx >> 8, v = idx & 255; float o = 0.f;
#pragma unroll
            for (int w = 0; w < 8; ++w) o += red[(t * 8 + w) * 256 + v];
            const int row = TP + 4 * b + t; OB[(size_t)row * DM + h * 256 + v] = f2bf(o); }
        LDS_BARRIER();
    }
}

DI void gla_gate(const Params& P) {
    unsigned char* ws = P.ws; const int tid = tid_(), lane = tid & 63; const int gw = bid_() * 8 + (tid >> 6), NW = gdim_() * 8;
    const bf16_t* QK = (const bf16_t*)(ws + O_R + R_QKVR); bf16_t* OB = (bf16_t*)(ws + O_R + R_OBUF); const float* gn = P.in[I_GLANORM];
    const int c16 = lane * 16;
    float g[16];
#pragma unroll
    for (int q = 0; q < 4; ++q) { const f32x4 gv = *(const f32x4*)(gn + c16 + 4 * q); g[4 * q] = gv[0]; g[4 * q + 1] = gv[1]; g[4 * q + 2] = gv[2]; g[4 * q + 3] = gv[3]; }
#pragma unroll 2
    for (int row = gw; row < T; row += NW) {
        float o[16], r[16];
        unpack8(*(const u32x4*)(OB + (size_t)row * DM + c16), o); unpack8(*(const u32x4*)(OB + (size_t)row * DM + c16 + 8), o + 8);
        unpack8(*(const u32x4*)(QK + (size_t)row * 3072 + 2048 + c16), r); unpack8(*(const u32x4*)(QK + (size_t)row * 3072 + 2048 + c16 + 8), r + 8);
        float sq = 0.f;
#pragma unroll
        for (int j = 0; j < 16; ++j) sq += o[j] * o[j];
        sq += __shfl_xor(sq, 1); sq += __shfl_xor(sq, 2); sq += __shfl_xor(sq, 4); sq += __shfl_xor(sq, 8);
        const float rs = rs_of(sq, 1.f / 256.f);
#pragma unroll
        for (int j = 0; j < 16; ++j) o[j] = o[j] * rs * g[j] * siluf_(r[j]);
        *(u32x4*)(OB + (size_t)row * DM + c16) = pack8(o); *(u32x4*)(OB + (size_t)row * DM + c16 + 8) = pack8(o + 8); }
}

DI void ssd_conv(const Params& P) {
    unsigned char* ws = P.ws; const int tid = tid_(); const int gt = bid_() * 512 + tid, NT = gdim_() * 512;
    const bf16_t* XBC = (const bf16_t*)(ws + O_R + R_XBC); bf16_t* XS = (bf16_t*)(ws + O_R + R_XBCS); const float* DTR = (const float*)(ws + O_R + R_DTR); float* DT = (float*)(ws + O_R + R_DT);
    const float* cw = P.in[I_SSMCW]; const float* cb = P.in[I_SSMCB]; const float* cs0 = P.in[I_SCONV];
    if (tid < 384) {
        const int c8 = tid * 8; float w[4][8], cbv[8];
#pragma unroll
        for (int jj = 0; jj < 4; ++jj) { const f32x4 a = *(const f32x4*)(cw + (size_t)jj * 3072 + c8), bq = *(const f32x4*)(cw + (size_t)jj * 3072 + c8 + 4);
#pragma unroll
            for (int j = 0; j < 4; ++j) { w[jj][j] = a[j]; w[jj][4 + j] = bq[j]; } }
        { const f32x4 a = *(const f32x4*)(cb + c8), bq = *(const f32x4*)(cb + c8 + 4);
#pragma unroll
          for (int j = 0; j < 4; ++j) { cbv[j] = a[j]; cbv[4 + j] = bq[j]; } }
        for (int it = bid_(); it < 640; it += gdim_()) {
            const bool prompt = it < 512; const int b = prompt ? (it >> 6) : (it - 512); const int t0 = prompt ? (it & 63) * 32 : 0; const int row0 = prompt ? it * 32 : TP + 4 * b; const int nrows = prompt ? 32 : 4;
            float h1[8], h2[8], h3[8];
            if (prompt) { if (t0 > 0) { unpack8(*(const u32x4*)(XBC + (size_t)(row0 - 1) * 3072 + c8), h1); unpack8(*(const u32x4*)(XBC + (size_t)(row0 - 2) * 3072 + c8), h2); unpack8(*(const u32x4*)(XBC + (size_t)(row0 - 3) * 3072 + c8), h3); }
                else {
#pragma unroll
                    for (int j = 0; j < 8; ++j) { h1[j] = 0.f; h2[j] = 0.f; h3[j] = 0.f; } } }
            else { const float* sp = cs0 + (size_t)b * 3 * 3072 + c8;
#pragma unroll
                for (int j = 0; j < 8; ++j) { h1[j] = sp[2 * 3072 + j]; h2[j] = sp[3072 + j]; h3[j] = sp[j]; } }
#pragma unroll 8
            for (int r = 0; r < nrows; ++r) { const int row = row0 + r, t = t0 + r; float cur[8], acc[8]; unpack8(*(const u32x4*)(XBC + (size_t)row * 3072 + c8), cur);
#pragma unroll
                for (int j = 0; j < 8; ++j) { acc[j] = siluf_(cbv[j] + w[3][j] * cur[j] + w[2][j] * h1[j] + w[1][j] * h2[j] + w[0][j] * h3[j]); h3[j] = h2[j]; h2[j] = h1[j]; h1[j] = cur[j]; }
                *(u32x4*)(XS + (size_t)row * 3072 + c8) = pack8(acc);
                if (prompt && t >= 2045) { float* o = P.out + OUT_CONVP + ((size_t)b * 3 + (t - 2045)) * 3072 + c8; *(f32x4*)o = (f32x4){cur[0], cur[1], cur[2], cur[3]}; *(f32x4*)(o + 4) = (f32x4){cur[4], cur[5], cur[6], cur[7]}; }
                if (!prompt && t >= 1) { float* o = P.out + OUT_CONVS + ((size_t)b * 3 + (t - 1)) * 3072 + c8; *(f32x4*)o = (f32x4){cur[0], cur[1], cur[2], cur[3]}; *(f32x4*)(o + 4) = (f32x4){cur[4], cur[5], cur[6], cur[7]}; } }
        }
    }
    const float* dtb = P.in[I_SSMDTB];
#pragma unroll 4
    for (int i = gt; i < T * 32; i += NT) DT[i] = softplusf_(DTR[i] + dtb[i & 31]);
}

DI void ssd_scan(const Params& P, LAS unsigned char* lds) {
    const int tid = tid_(), wid = __builtin_amdgcn_readfirstlane(tid >> 6), lane = tid & 63, fr = lane & 15, fq = lane >> 4;
    unsigned char* ws = P.ws;
    const bf16_t* XS = (const bf16_t*)(ws + O_R + R_XBCS); const bf16_t* Z = (const bf16_t*)(ws + O_R + R_Z); const float* DT = (const float*)(ws + O_R + R_DT);
    bf16_t* YB = (bf16_t*)(ws + O_R + R_YBUF); float* SSS = (float*)(ws + O_ST) + ST_SSSP;
    constexpr int SSET = 9216 + 9216 + 17408 + 18432;
    LAS bf16_t* Sb0 = (LAS bf16_t*)(lds + 18432);
    const int mb = wid >> 1, hb = wid & 1;
    for (int it = bid_(); it < 256; it += gdim_()) {
        const int h = it & 31, b = it >> 5, g = h >> 3;
        const float a = -__expf(P.in[I_SSMALOG][h]); const float dsk = P.in[I_SSMD][h];
        f32x4 Sacc[4];
#pragma unroll
        for (int i = 0; i < 4; ++i) Sacc[i] = (f32x4){0.f, 0.f, 0.f, 0.f};
        for (int i = tid; i < 64 * 136 / 2; i += 512) ((LAS unsigned*)Sb0)[i] = 0u;
        float dtv; u32x4 xw, bw[2]; bf16x8 ca[4], bbf[2][4];
#define SSD_LOAD(ROW0, DTV, CA) do { \
            DTV = DT[(size_t)((ROW0) + lane) * 32 + h]; \
            xw = *(const u32x4*)(XS + (size_t)((ROW0) + lane) * 3072 + h * 64 + wid * 8); \
            _Pragma("unroll") for (int i_ = 0; i_ < 2; ++i_) bw[i_] = *(const u32x4*)(XS + (size_t)((ROW0) + lane) * 3072 + 2048 + g * 128 + (wid + 8 * i_) * 8); \
            _Pragma("unroll") for (int ks_ = 0; ks_ < 4; ++ks_) CA[ks_] = *(const bf16x8*)(XS + (size_t)((ROW0) + 16 * mb + fr) * 3072 + 2560 + g * 128 + 32 * ks_ + 8 * fq); \
            _Pragma("unroll") for (int i_ = 0; i_ < 2; ++i_) _Pragma("unroll") for (int ks_ = 0; ks_ < 4; ++ks_) bbf[i_][ks_] = *(const bf16x8*)(XS + (size_t)((ROW0) + 16 * (2 * hb + i_) + fr) * 3072 + 2048 + g * 128 + 32 * ks_ + 8 * fq); } while (0)
        SSD_LOAD(b * 2048, dtv, ca);
        for (int n = 0; n < 32; ++n) {
            const int row0 = b * 2048 + 64 * n;
            LAS unsigned char* sb_ = lds + (n & 1) * SSET; LAS unsigned char* so_ = lds + ((n & 1) ^ 1) * SSET;
            LAS bf16_t* Pm = (LAS bf16_t*)sb_; LAS bf16_t* Xt = (LAS bf16_t*)(sb_ + 9216); LAS bf16_t* Sb = (LAS bf16_t*)(sb_ + 18432); LAS bf16_t* BWt = (LAS bf16_t*)(sb_ + 35840);
            LAS bf16_t* Sbn = (LAS bf16_t*)(so_ + 18432);
            float cum = dtv * a;
#pragma unroll
            for (int of = 1; of < 64; of <<= 1) { const float o = __shfl_up(cum, of); if (lane >= of) cum += o; }
            const float cl = __shfl(cum, 63); const float wend = __expf(cl - cum) * dtv;
            { const int p8 = wid * 8; const bf16_t* e = (const bf16_t*)&xw;
#pragma unroll
              for (int j = 0; j < 8; ++j) Xt[(p8 + j) * 72 + lane] = e[j]; }
#pragma unroll
            for (int i = 0; i < 2; ++i) { const int n8 = (wid + 8 * i) * 8; float f[8]; unpack8(bw[i], f);
#pragma unroll
                for (int j = 0; j < 8; ++j) BWt[(n8 + j) * 72 + lane] = f2bf(f[j] * wend); }
            float cumt[4];
#pragma unroll
            for (int j = 0; j < 4; ++j) cumt[j] = __shfl(cum, 16 * mb + 4 * fq + j);
#pragma unroll
            for (int i = 0; i < 2; ++i) { const int nb = 2 * hb + i; f32x4 sc = {0.f, 0.f, 0.f, 0.f};
#pragma unroll
                for (int ks = 0; ks < 4; ++ks) sc = MFMA16(ca[ks], bbf[i][ks], sc);
                const int s = 16 * nb + fr; const float cums = __shfl(cum, s), dts = __shfl(dtv, s);
#pragma unroll
                for (int j = 0; j < 4; ++j) { const int t = 16 * mb + 4 * fq + j; Pm[t * 72 + s] = f2bf(s <= t ? sc[j] * __expf(cumt[j] - cums) * dts : 0.f); } }
            LDS_BARRIER();
            float dtn = dtv; bf16x8 cn[4];
#pragma unroll
            for (int ks = 0; ks < 4; ++ks) cn[ks] = ca[ks];
            if (n + 1 < 32) SSD_LOAD(row0 + 64, dtn, cn);
            f32x4 yi[2], ye[2];
#pragma unroll
            for (int i = 0; i < 2; ++i) { yi[i] = (f32x4){0.f, 0.f, 0.f, 0.f}; ye[i] = (f32x4){0.f, 0.f, 0.f, 0.f}; }
#pragma unroll
            for (int k2 = 0; k2 < 2; ++k2) { const bf16x8 am = *(const LAS bf16x8*)(Pm + (16 * mb + fr) * 72 + 32 * k2 + 8 * fq);
#pragma unroll
                for (int i = 0; i < 2; ++i) { const bf16x8 bb = *(const LAS bf16x8*)(Xt + (16 * (2 * hb + i) + fr) * 72 + 32 * k2 + 8 * fq); yi[i] = MFMA16(am, bb, yi[i]); } }
#pragma unroll
            for (int ks = 0; ks < 4; ++ks)
#pragma unroll
                for (int i = 0; i < 2; ++i) { const bf16x8 bb = *(const LAS bf16x8*)(Sb + (16 * (2 * hb + i) + fr) * 136 + 32 * ks + 8 * fq); ye[i] = MFMA16(ca[ks], bb, ye[i]); }
#pragma unroll
            for (int j = 0; j < 4; ++j) { const int tl = 16 * mb + 4 * fq + j, row = row0 + tl; const float ec = __expf(cumt[j]);
#pragma unroll
                for (int i = 0; i < 2; ++i) { const int p = 16 * (2 * hb + i) + fr; const float xv = bf2f(Xt[p * 72 + tl]);
                    YB[(size_t)row * 2048 + h * 64 + p] = f2bf(yi[i][j] + ec * ye[i][j] + dsk * xv); } }
            { const float ecl = __expf(cl);
#pragma unroll
              for (int i = 0; i < 4; ++i) Sacc[i] *= ecl; }
#pragma unroll
            for (int k2 = 0; k2 < 2; ++k2) { const bf16x8 am = *(const LAS bf16x8*)(BWt + (16 * wid + fr) * 72 + 32 * k2 + 8 * fq);
#pragma unroll
                for (int i = 0; i < 4; ++i) { const bf16x8 bb = *(const LAS bf16x8*)(Xt + (16 * i + fr) * 72 + 32 * k2 + 8 * fq); Sacc[i] = MFMA16(am, bb, Sacc[i]); } }
#pragma unroll
            for (int i = 0; i < 4; ++i) { u32x2 w; w.x = pk2(Sacc[i][0], Sacc[i][1]); w.y = pk2(Sacc[i][2], Sacc[i][3]); *(LAS u32x2*)(Sbn + (16 * i + fr) * 136 + 16 * wid + 4 * fq) = w; }
            dtv = dtn;
#pragma unroll
            for (int ks = 0; ks < 4; ++ks) ca[ks] = cn[ks];
        }
#undef SSD_LOAD
        float* SO = P.out + OUT_SSMP + ((size_t)(b * 32 + h) * 64) * 128;
#pragma unroll
        for (int i = 0; i < 4; ++i) __builtin_nontemporal_store(Sacc[i], (f32x4*)(SO + (size_t)(16 * i + fr) * 128 + 16 * wid + 4 * fq));
        LDS_BARRIER();
    }
    { const int gw = bid_() * 8 + wid, NW = gdim_() * 8; const int n4 = (lane & 31) * 4, ph = lane >> 5;
      for (int it = gw; it < 4096; it += NW) { const int b = it >> 5, h = it & 31, g = h >> 3;
          const float a = -__expf(P.in[I_SSMALOG][h]); const float dsk = P.in[I_SSMD][h];
          const float* S0 = P.in[I_SSSM] + ((size_t)(b * 32 + h) * 64) * 128 + n4; float* SO = P.out + OUT_SSMS + ((size_t)(b * 32 + h) * 64) * 128 + n4;
#pragma unroll
          for (int half = 0; half < 2; ++half) { f32x4 S[16];
#pragma unroll
              for (int i = 0; i < 16; ++i) S[i] = __builtin_nontemporal_load((const f32x4*)(S0 + (size_t)(ph + 2 * (16 * half + i)) * 128));
#pragma unroll 1
              for (int t = 0; t < 4; ++t) { const int row = TP + 4 * b + t; const float dtv = DT[(size_t)row * 32 + h]; const float dec = __expf(dtv * a);
                  const u32x2 bw = *(const u32x2*)(XS + (size_t)row * 3072 + 2048 + g * 128 + n4), cw2 = *(const u32x2*)(XS + (size_t)row * 3072 + 2560 + g * 128 + n4);
                  const f32x4 Bv = {bflo(bw.x), bfhi(bw.x), bflo(bw.y), bfhi(bw.y)}, Cv = {bflo(cw2.x), bfhi(cw2.x), bflo(cw2.y), bfhi(cw2.y)}; float ysel = 0.f;
#pragma unroll
                  for (int i = 0; i < 16; ++i) { const int p = ph + 2 * (16 * half + i); const float xv = bf2f(XS[(size_t)row * 3072 + h * 64 + p]);
                      S[i] = S[i] * dec + Bv * (dtv * xv);
                      float yp = (S[i][0] * Cv[0] + S[i][1] * Cv[1]) + (S[i][2] * Cv[2] + S[i][3] * Cv[3]);
                      yp += __shfl_xor(yp, 1); yp += __shfl_xor(yp, 2); yp += __shfl_xor(yp, 4); yp += __shfl_xor(yp, 8); yp += __shfl_xor(yp, 16);
                      ysel = ((lane & 31) == i) ? yp : ysel; }
                  if ((lane & 31) < 16) { const int p = ph + 2 * (16 * half + (lane & 31)); const float xv = bf2f(XS[(size_t)row * 3072 + h * 64 + p]);
                      YB[(size_t)row * 2048 + h * 64 + p] = f2bf(ysel + dsk * xv); } }
#pragma unroll
              for (int i = 0; i < 16; ++i) __builtin_nontemporal_store(S[i], (f32x4*)(SO + (size_t)(ph + 2 * (16 * half + i)) * 128)); } } }
}

DI void ssd_norm(const Params& P) {
    unsigned char* ws = P.ws; const int tid = tid_(), lane = tid & 63; const int gw = bid_() * 8 + (tid >> 6), NW = gdim_() * 8;
    bf16_t* YB = (bf16_t*)(ws + O_R + R_YBUF); const bf16_t* Z = (const bf16_t*)(ws + O_R + R_Z);
#pragma unroll 4
    for (int item = gw; item < T * 4; item += NW) { const size_t off = (size_t)(item >> 2) * 2048 + (item & 3) * 512 + lane * 8;
        const u32x4 yw = *(const u32x4*)(YB + off), zw = *(const u32x4*)(Z + off); float f[8], z[8]; unpack8(yw, f); unpack8(zw, z);
        float sq = 0.f;
#pragma unroll
        for (int j = 0; j < 8; ++j) { f[j] *= siluf_(z[j]); sq += f[j] * f[j]; }
#pragma unroll
        for (int o = 32; o >= 1; o >>= 1) sq += __shfl_xor(sq, o);
        const float rs = rs_of(sq, 1.f / 512.f);
#pragma unroll
        for (int j = 0; j < 8; ++j) f[j] *= rs;
        *(u32x4*)(YB + off) = pack8(f); }
}

DI void final_norm(const Params& P) {
    unsigned char* ws = P.ws; const int gt = bid_() * 512 + tid_(), NT = gdim_() * 512;
    const float* X = (const float*)(ws + O_X); const float* SS = (const float*)(ws + O_ST); const float* g = P.in[I_NFIN];
#pragma unroll 4
    for (int i = gt; i < T * 256; i += NT) { const int row = i >> 8, c4 = (i & 255) * 4; const float rs = rs_of(sum16(SS + (size_t)row * 16), 1.f / 1024.f);
        const f32x4 v = *(const f32x4*)(X + (size_t)row * DM + c4) * *(const f32x4*)(g + c4) * rs; __builtin_nontemporal_store(v, (f32x4*)(P.out + OUT_Y + (size_t)row * DM + c4)); }
}

__constant__ unsigned char PH_KIND[NPHASES] = { K_P0,
    K_A, K_B, K_GM1, K_GM2, K_GM3, K_D, K_E, K_PP, K_F,
    K_A, K_B, K_PL1, K_PL2, K_D, K_E, K_PP, K_F,
    K_A, K_B, K_GL1, K_GL2, K_GL3, K_GL4, K_GL5, K_D, K_E, K_PP, K_F,
    K_A, K_B, K_SS1, K_SS2, K_SS3, K_SS4, K_SS5, K_D, K_E, K_PP, K_F,
    K_FIN };
__constant__ unsigned char PH_LAYER[NPHASES] = { 0, 0, 0, 0, 0, 0, 0, 0, 0, 0, 1, 1, 1, 1, 1, 1, 1, 1, 2, 2, 2, 2, 2, 2, 2, 2, 2, 2, 2, 3, 3, 3, 3, 3, 3, 3, 3, 3, 3, 3, 3 };

DI void run_phase(const Params& P, int ph, LAS unsigned char* lds) {
    const int kind = PH_KIND[ph], l = PH_LAYER[ph]; unsigned char* ws = P.ws;
    GemmD g; bool is_gemm = true;
    g.A = (const bf16_t*)(ws + O_XB); g.lda = 1024; g.ldb = 1024; g.a_pn_off = 0; g.nM = 66; g.nN = 4; g.K = 1024; g.Bt = nullptr;
    switch (kind) {
    case K_A: case K_D: g.Bt = (const bf16_t*)(ws + (kind == K_A ? O_W1 : O_W2) + (size_t)l * SZ_W1); g.nN = 22; if (kind == K_A && l > 0) g.A = (const bf16_t*)(ws + O_XB2); break;
    case K_B: case K_E: g.A = (const bf16_t*)(ws + O_R + R_ACT); g.lda = FF; g.ldb = FF; g.K = FF; g.Bt = (const bf16_t*)(ws + (kind == K_B ? O_D1 : O_D2) + (size_t)l * SZ_D1); break;
    case K_PP: g.A = (const bf16_t*)(ws + O_PBF); g.lda = 256; g.ldb = 256; g.K = 256; g.Bt = (const bf16_t*)(ws + O_PPW + (size_t)l * SZ_PPW); break;
    case K_F: g.Bt = (const bf16_t*)(ws + O_PG + (size_t)l * SZ_SQ); break;
    case K_GM1: g.Bt = (const bf16_t*)(ws + O_GMIN); g.nN = 8; break;
    case K_GM3: g.A = (const bf16_t*)(ws + O_R + R_GU); g.Bt = (const bf16_t*)(ws + O_GMOUT); break;
    case K_PL2: g.A = (const bf16_t*)(ws + O_R + R_DIFF); g.a_pn_off = 256; g.ldb = 256; g.K = 256; g.Bt = (const bf16_t*)(ws + O_POOLW); break;
    case K_GL1: g.Bt = (const bf16_t*)(ws + O_GLAIN); g.nN = 13; break;
    case K_GL5: g.A = (const bf16_t*)(ws + O_R + R_OBUF); g.Bt = (const bf16_t*)(ws + O_GLAOUT); break;
    case K_SS1: g.Bt = (const bf16_t*)(ws + O_SSMIN); g.nN = 21; break;
    case K_SS5: g.A = (const bf16_t*)(ws + O_R + R_YBUF); g.lda = 2048; g.ldb = 2048; g.K = 2048; g.Bt = (const bf16_t*)(ws + O_SSMOUT); break;
    default: is_gemm = false; break;
    }
    if (is_gemm) {
        const bool mini = (g.nN == 4);
        if (mini) g.nM = 64;
        gemm_phase(lds, g, kind, l);
        if (mini) mini_gemm(lds, g, kind, l);
        if (kind == K_A) conv_p(fresh_params(), l);
        return; }
    switch (kind) {
    case K_P0: phase0(P, lds); break;
    case K_GM2: gm_spatial(P, lds); break;
    case K_PL1: pool_prep(P, lds); break;
    case K_GL2: gla_prep(P, lds); break;
    case K_GL3: gla_scan(P, lds); break;
    case K_GL4: gla_gate(P); break;
    case K_SS2: ssd_conv(P); break;
    case K_SS3: ssd_scan(P, lds); break;
    case K_SS4: ssd_norm(P); break;
    case K_FIN: final_norm(P); break;
    default: break;
    }
}


#define XB_TMO      128
#define XB_XCNT(j)  (256  + 64 * (j))
#define XB_XSUB(j)  (1280 + 64 * (j))
#define XB_XGEN(j)  (2304 + 64 * (j))
#define XB_TOP      3328
#define XB_TOPGEN   3392
#define XCD_BAR_WORDS 3456
#define XB_SPIN_CAP (1u << 18)
__device__ __forceinline__ unsigned xb_ld(unsigned* p)              { return __hip_atomic_load(p, __ATOMIC_RELAXED, __HIP_MEMORY_SCOPE_AGENT); }
__device__ __forceinline__ unsigned xb_add(unsigned* p, unsigned v) { return __hip_atomic_fetch_add(p, v, __ATOMIC_RELAXED, __HIP_MEMORY_SCOPE_AGENT); }
__device__ __forceinline__ unsigned xb_xcc_id() { return (unsigned)__builtin_amdgcn_s_getreg((3 << 11) | 20) & 0xFu; }
#define XB_SPIN(cond, bar) do { unsigned _sp = 0; while (cond) { __builtin_amdgcn_s_sleep(1); \
    if ((++_sp & 255u) == 0u) { if (xb_ld(&(bar)[XB_TMO])) break; if (_sp > XB_SPIN_CAP) { atomicAdd(&(bar)[XB_TMO], 1u); break; } } } } while (0)
struct XcdBarrier { unsigned* bar; unsigned x; volatile LAS unsigned* st; };
__device__ __forceinline__ XcdBarrier xcd_barrier_post(unsigned* bar, volatile LAS unsigned* st) {
    XcdBarrier b; b.bar = bar; b.x = xb_xcc_id(); b.st = st;
    if (threadIdx.x == 0) (void)xb_add(&bar[XB_XCNT(b.x)], 1u);
    return b;
}
__device__ __forceinline__ void xcd_barrier_complete(unsigned* bar, unsigned x, unsigned& nloc, unsigned& nx) {
    const unsigned G = gridDim.x * gridDim.y * gridDim.z;
    unsigned sum, cnt, mine, sp = 0u;
    for (;;) {
        sum = 0u; cnt = 0u; mine = 0u;
#pragma unroll
        for (unsigned j = 0; j < 16; ++j) { const unsigned c = xb_ld(&bar[XB_XCNT(j)]); sum += c; cnt += (c > 0u) ? 1u : 0u; mine = (j == x) ? c : mine; }
        if (sum == G) break;
        __builtin_amdgcn_s_sleep(1);
        if ((++sp & 255u) == 0u) { if (xb_ld(&bar[XB_TMO])) break; if (sp > XB_SPIN_CAP) { atomicAdd(&bar[XB_TMO], 1u); break; } }
    }
    nloc = mine > 0u ? mine : 1u; nx = cnt > 0u ? cnt : 1u;
}
__device__ __forceinline__ void xcd_barrier(const XcdBarrier& b) {
    asm volatile("s_waitcnt vmcnt(0)" ::: "memory");
    __syncthreads();
    if (threadIdx.x == 0) {
        unsigned* bar = b.bar;
        __builtin_amdgcn_s_waitcnt(0);
        unsigned nloc = b.st[0], nx = b.st[1];
        if (nloc == 0u) { xcd_barrier_complete(bar, b.x, nloc, nx); b.st[0] = nloc; b.st[1] = nx; }
        const unsigned old = xb_add(&bar[XB_XSUB(b.x)], 1u);
        const unsigned gen = old / nloc;
        if (old + 1u == (gen + 1u) * nloc) {
            __builtin_amdgcn_fence(__ATOMIC_RELEASE, "agent");
            asm volatile("s_waitcnt vmcnt(0)" ::: "memory");
            const unsigned og = xb_add(&bar[XB_TOP], 1u);
            const unsigned tg = og / nx;
            if (og + 1u == (tg + 1u) * nx) xb_add(&bar[XB_TOPGEN], 1u);
            else XB_SPIN(xb_ld(&bar[XB_TOPGEN]) == tg, bar);
            __builtin_amdgcn_fence(__ATOMIC_ACQUIRE, "agent");
            xb_add(&bar[XB_XGEN(b.x)], 1u);
            asm volatile("s_waitcnt vmcnt(0)" ::: "memory");
        } else {
            XB_SPIN(xb_ld(&bar[XB_XGEN(b.x)]) == gen, bar);
            __builtin_amdgcn_fence(__ATOMIC_ACQUIRE, "agent");
            asm volatile("s_waitcnt vmcnt(0)" ::: "memory");
        }
    }
    __syncthreads();
}

__global__ void __launch_bounds__(512, 2) mega(Params P, int ph_lo, int ph_hi) {
    extern __shared__ __attribute__((aligned(16))) unsigned char smem[];
    LAS unsigned char* lds = (LAS unsigned char*)smem;
    if (ph_lo > ph_hi) cg::this_grid().sync();
    volatile LAS unsigned* st = (volatile LAS unsigned*)(lds + 131072);
    if (threadIdx.x < 2) st[threadIdx.x] = 0u;
    __syncthreads();
    const XcdBarrier bar = xcd_barrier_post((unsigned*)(P.ws + O_BAR), st);
    for (int ph = ph_lo; ph < ph_hi; ++ph) {
        if (ph > ph_lo) xcd_barrier(bar);
        run_phase(fresh_params(), ph, lds);
    }
}

constexpr int LDS_BYTES = 131072 + 16;

extern "C" void kernel_launch(void* const* d_in, const int* in_sizes, int n_in, void* d_out, int out_size, void* d_ws, size_t ws_size, hipStream_t stream) {
    static int grid = 0;
    if (grid == 0) {
        if (n_in != N_IN || ws_size < WS_TOTAL) { fprintf(stderr, "kernel_launch: n_in %d (want %d), ws %zu (want >= %zu)\n", n_in, (int)N_IN, ws_size, (size_t)WS_TOTAL); grid = -1; return; }
        int dev = 0, cus = 0, per_cu = 0;
        hipGetDevice(&dev); hipDeviceGetAttribute(&cus, hipDeviceAttributeMultiprocessorCount, dev);
        if (hipFuncSetAttribute((const void*)mega, hipFuncAttributeMaxDynamicSharedMemorySize, LDS_BYTES) != hipSuccess) { fprintf(stderr, "kernel_launch: hipFuncSetAttribute failed\n"); grid = -1; return; }
        if (hipOccupancyMaxActiveBlocksPerMultiprocessor(&per_cu, (const void*)mega, 512, LDS_BYTES) != hipSuccess || per_cu < 1) { fprintf(stderr, "kernel_launch: occupancy query says %d\n", per_cu); per_cu = 1; }
        (void)hipGetLastError();
        grid = cus;
    }
    if (grid < 0) return;
    if (hipMemsetAsync((char*)d_ws + O_BAR, 0, 16384, stream) != hipSuccess) { fprintf(stderr, "kernel_launch: memset of the barrier words failed\n"); return; }
    Params p{};
    for (int i = 0; i < N_IN; ++i) p.in[i] = (const float*)d_in[i];
    p.out = (float*)d_out; p.ws = (unsigned char*)d_ws;
    int lo = 0, hi = NPHASES;
    void* args[] = {&p, &lo, &hi};
    hipError_t e = hipLaunchCooperativeKernel((const void*)mega, dim3(grid), dim3(512), args, LDS_BYTES, stream);
    if (e != hipSuccess) fprintf(stderr, "kernel_launch: cooperative launch failed: %s (grid %d)\n", hipGetErrorString(e), grid);
}
```
